# Optimizing an MI355X kernel written in HIP

```python
import jax, jax.numpy as jnp
from jax import lax
import numpy as np

D_MODEL = 1024
BATCH = 4
SEQ = 4096
DEPTH = 1

N_META = 16
BLOCK = 128
PAD_FRONT = BLOCK - N_META
HEAD_DIM = 64
ATTN_WIDTH = D_MODEL // 2
LRU_WIDTH = D_MODEL - ATTN_WIDTH
N_Q_HEADS = ATTN_WIDTH // HEAD_DIM
N_KV_HEADS = 2
Q_PER_KV = N_Q_HEADS // N_KV_HEADS
KV_WIDTH = N_KV_HEADS * HEAD_DIM
WINDOW = 128
LRU_BLOCKS = 8
LRU_BLOCK_W = LRU_WIDTH // LRU_BLOCKS
CONV_W = 4
LRU_C = 8.0
IN_SPLITS = (ATTN_WIDTH, KV_WIDTH, KV_WIDTH, LRU_WIDTH, LRU_WIDTH)
IN_COLS = ATTN_WIDTH + 2 * KV_WIDTH + 2 * LRU_WIDTH
N_GROUPS = 4
EXPERTS_PER_GROUP = 8
N_EXPERTS = N_GROUPS * EXPERTS_PER_GROUP
TOP_K = 2
D_FF_EXPERT = D_MODEL // 2
MOE_BLOCK = 128
ALPHA = (2.0 * DEPTH) ** 0.25
BETA = (8.0 * DEPTH) ** -0.25
EPS = 1e-5
NEG = -1e30

kernel_name = 'hymba_swa_rglru_hmoe_deepnorm'


def layer_norm(x, g, b):
    xf = x.astype(jnp.float32)
    mu = jnp.mean(xf, axis=-1, keepdims=True)
    var = jnp.mean(jnp.square(xf - mu), axis=-1, keepdims=True)
    return ((xf - mu) * lax.rsqrt(var + EPS) * g.astype(jnp.float32) + b.astype(jnp.float32)).astype(x.dtype)


def rms_norm(x, g):
    xf = x.astype(jnp.float32)
    ms = jnp.mean(jnp.square(xf), axis=-1, keepdims=True)
    return (xf * lax.rsqrt(ms + EPS) * g.astype(jnp.float32)).astype(x.dtype)


def alibi_slopes():
    return jnp.exp2(-8.0 * jnp.arange(1, N_Q_HEADS + 1, dtype=jnp.float32) / N_Q_HEADS)


def sliding_window_attention(q, k, v, sinks):
    bsz, l_len = q.shape[0], q.shape[1]
    nb = l_len // BLOCK
    f32 = jnp.float32
    qb = q.astype(f32).reshape(bsz, nb, BLOCK, N_KV_HEADS, Q_PER_KV, HEAD_DIM)
    kb = k.astype(f32).reshape(bsz, nb, BLOCK, N_KV_HEADS, HEAD_DIM)
    vb = v.astype(f32).reshape(bsz, nb, BLOCK, N_KV_HEADS, HEAD_DIM)
    shift = ((0, 0), (1, 0), (0, 0), (0, 0), (0, 0))
    kw = jnp.concatenate([jnp.pad(kb, shift)[:, :-1], kb], axis=2)
    vw = jnp.concatenate([jnp.pad(vb, shift)[:, :-1], vb], axis=2)
    scores = jnp.einsum('bnqhgd,bnkhd->bnhgqk', qb, kw) * (HEAD_DIM ** -0.5)
    qi = np.arange(BLOCK)[:, None]
    kj = np.arange(2 * BLOCK)[None, :]
    dist = qi - kj + BLOCK
    band = (dist >= 0) & (dist < WINDOW)
    key_pos = np.arange(nb)[:, None] * BLOCK - BLOCK + np.arange(2 * BLOCK)[None, :]
    key_valid = key_pos >= PAD_FRONT
    mask = band[None, :, :] & key_valid[:, None, :]
    slopes = alibi_slopes().reshape(N_KV_HEADS, Q_PER_KV, 1, 1)
    logits = scores - slopes * jnp.asarray(dist, f32)
    logits = jnp.where(mask[None, :, None, None], logits, NEG)
    sink_col = jnp.broadcast_to(sinks.astype(f32).reshape(N_KV_HEADS, Q_PER_KV, 1, 1), logits.shape[:-1] + (1,))
    probs = jax.nn.softmax(jnp.concatenate([logits, sink_col], axis=-1), axis=-1)[..., :-1]
    out = jnp.einsum('bnhgqk,bnkhd->bnqhgd', probs, vw)
    return out.reshape(bsz, l_len, ATTN_WIDTH).astype(q.dtype)


def causal_depthwise_conv(x, w, b):
    y = lax.conv_general_dilated(x, w[:, None, :].astype(x.dtype), window_strides=(1,),
                                 padding=[(CONV_W - 1, 0)],
                                 dimension_numbers=('NWC', 'WIO', 'NWC'),
                                 feature_group_count=x.shape[-1])
    return y + b.astype(x.dtype)


def _linear_combine(c1, c2):
    a1, b1 = c1
    a2, b2 = c2
    return a1 * a2, a2 * b1 + b2


def rg_lru(xc, w_a, b_a, w_x, b_x, lam):
    bsz, t_len, width = xc.shape
    f32 = jnp.float32
    xf = xc.astype(f32)
    xb = xf.reshape(bsz, t_len, LRU_BLOCKS, LRU_BLOCK_W)
    r = jax.nn.sigmoid(jnp.einsum('btnc,ncd->btnd', xb, w_a.astype(f32)) + b_a.astype(f32)).reshape(bsz, t_len, width)
    i = jax.nn.sigmoid(jnp.einsum('btnc,ncd->btnd', xb, w_x.astype(f32)) + b_x.astype(f32)).reshape(bsz, t_len, width)
    log_a = -LRU_C * r * jax.nn.softplus(-lam.astype(f32))
    a = jnp.exp(log_a)
    u = jnp.sqrt(-jnp.expm1(2.0 * log_a)) * (i * xf)
    _, h = lax.associative_scan(_linear_combine, (a, u), axis=1)
    return h.astype(xc.dtype)


def token_mixer(x, w_in, conv_w, conv_b, lru_wa, lru_ba, lru_wx, lru_bx, lru_lambda,
                attn_sinks, g_attn, g_lru, w_out):
    bsz, t_len, _ = x.shape
    proj = jnp.einsum('btd,dc->btc', x, w_in)
    offs = np.cumsum(IN_SPLITS)[:-1].tolist()
    q, k, v, xr, yr = jnp.split(proj, offs, axis=-1)
    pad = ((0, 0), (PAD_FRONT, 0), (0, 0))
    l_len = t_len + PAD_FRONT
    qp = jnp.pad(q, pad).reshape(bsz, l_len, N_Q_HEADS, HEAD_DIM)
    kp = jnp.pad(k, pad).reshape(bsz, l_len, N_KV_HEADS, HEAD_DIM)
    vp = jnp.pad(v, pad).reshape(bsz, l_len, N_KV_HEADS, HEAD_DIM)
    attn = sliding_window_attention(qp, kp, vp, attn_sinks)[:, PAD_FRONT:]
    xc = causal_depthwise_conv(xr, conv_w, conv_b)
    lru = rg_lru(xc, lru_wa, lru_ba, lru_wx, lru_bx, lru_lambda) * jax.nn.gelu(yr)
    merged = jnp.concatenate([rms_norm(attn, g_attn), rms_norm(lru, g_lru)], axis=-1)
    return jnp.einsum('btc,cd->btd', merged, w_out)


def hierarchical_moe(h, w_group, b_group, w_router, b_router, w_gate, w_up, w_down):
    bsz, t_len, d = h.shape
    f32 = jnp.float32
    xf = h.reshape(-1, d)
    n_tok = xf.shape[0]
    x32 = xf.astype(f32)
    g_logits = x32 @ w_group.astype(f32) + b_group.astype(f32)
    g_prob = jax.nn.softmax(g_logits, axis=-1)
    g_idx = jnp.argmax(g_logits, axis=-1)
    g_w = jnp.take_along_axis(g_prob, g_idx[:, None], axis=-1)
    e_logits = jnp.einsum('nd,gde->nge', x32, w_router.astype(f32)) + b_router.astype(f32)
    e_logits = jnp.take_along_axis(e_logits, g_idx[:, None, None], axis=1)[:, 0]
    top_v, top_i = lax.top_k(e_logits, TOP_K)
    gates = g_w * jax.nn.softmax(top_v, axis=-1)
    expert = g_idx[:, None].astype(jnp.int32) * EXPERTS_PER_GROUP + top_i.astype(jnp.int32)
    n_slots = n_tok * TOP_K
    flat_e = expert.reshape(-1)
    flat_tok = jnp.arange(n_slots, dtype=jnp.int32) // TOP_K
    flat_g = gates.reshape(-1)
    order = jnp.argsort(flat_e)
    se = flat_e[order]
    counts = jnp.bincount(flat_e, length=N_EXPERTS).astype(jnp.int32)
    starts = jnp.cumsum(counts) - counts
    padded = (counts + MOE_BLOCK - 1) // MOE_BLOCK * MOE_BLOCK
    pends = jnp.cumsum(padded)
    pstarts = pends - padded
    dest = pstarts[se] + (jnp.arange(n_slots, dtype=jnp.int32) - starts[se])
    n_blocks = -(-n_slots // MOE_BLOCK) + N_EXPERTS
    cap = n_blocks * MOE_BLOCK
    tok_buf = jnp.zeros((cap,), jnp.int32).at[dest].set(flat_tok[order])
    gate_buf = jnp.zeros((cap,), f32).at[dest].set(flat_g[order])
    block_start = jnp.arange(n_blocks, dtype=jnp.int32) * MOE_BLOCK
    block_e = jnp.minimum(jnp.searchsorted(pends, block_start, side='right'), N_EXPERTS - 1)

    def run_block(args):
        toks, e = args
        xb = xf[toks]
        return (jax.nn.silu(xb @ w_gate[e]) * (xb @ w_up[e])) @ w_down[e]

    yb = lax.map(run_block, (tok_buf.reshape(n_blocks, MOE_BLOCK), block_e))
    y = jnp.zeros((n_tok, d), f32).at[tok_buf].add(yb.reshape(cap, d).astype(f32) * gate_buf[:, None])
    return y.reshape(bsz, t_len, d).astype(h.dtype)


def setup_inputs(seed: int = 0) -> dict:
    key = jax.random.key(seed)
    ks = jax.random.split(key, 26)
    f32 = jnp.float32

    def nrm(k, shape, scale):
        return jax.random.normal(k, shape, f32) * scale

    x = nrm(ks[0], (BATCH, SEQ, D_MODEL), 1.0)
    meta_tokens = nrm(ks[1], (N_META, D_MODEL), 1.0)
    col_scale = jnp.concatenate([jnp.ones((ATTN_WIDTH + KV_WIDTH,), f32),
                                 jnp.full((KV_WIDTH,), BETA, f32),
                                 jnp.ones((2 * LRU_WIDTH,), f32)])
    w_in = nrm(ks[2], (DEPTH, D_MODEL, IN_COLS), D_MODEL ** -0.5) * col_scale
    conv_w = nrm(ks[3], (DEPTH, CONV_W, LRU_WIDTH), CONV_W ** -0.5)
    conv_b = nrm(ks[4], (DEPTH, LRU_WIDTH), 0.01)
    lru_wa = nrm(ks[5], (DEPTH, LRU_BLOCKS, LRU_BLOCK_W, LRU_BLOCK_W), LRU_BLOCK_W ** -0.5)
    lru_ba = nrm(ks[6], (DEPTH, LRU_BLOCKS, LRU_BLOCK_W), 0.01)
    lru_wx = nrm(ks[7], (DEPTH, LRU_BLOCKS, LRU_BLOCK_W, LRU_BLOCK_W), LRU_BLOCK_W ** -0.5)
    lru_bx = nrm(ks[8], (DEPTH, LRU_BLOCKS, LRU_BLOCK_W), 0.01)
    base = jax.random.uniform(ks[9], (DEPTH, LRU_WIDTH), f32, 0.9, 0.999)
    lru_lambda = jnp.log(base) - jnp.log1p(-base)
    attn_sinks = nrm(ks[10], (DEPTH, N_Q_HEADS), 1.0)
    g_attn = 1.0 + nrm(ks[11], (DEPTH, ATTN_WIDTH), 0.02)
    g_lru = 1.0 + nrm(ks[12], (DEPTH, LRU_WIDTH), 0.02)
    w_out = nrm(ks[13], (DEPTH, ATTN_WIDTH + LRU_WIDTH, D_MODEL), D_MODEL ** -0.5 * BETA)
    ln1_g = 1.0 + nrm(ks[14], (DEPTH, D_MODEL), 0.02)
    ln1_b = nrm(ks[15], (DEPTH, D_MODEL), 0.01)
    w_group = nrm(ks[16], (DEPTH, D_MODEL, N_GROUPS), D_MODEL ** -0.5)
    b_group = nrm(ks[17], (DEPTH, N_GROUPS), 0.01)
    w_router = nrm(ks[18], (DEPTH, N_GROUPS, D_MODEL, EXPERTS_PER_GROUP), D_MODEL ** -0.5)
    b_router = nrm(ks[19], (DEPTH, N_GROUPS, EXPERTS_PER_GROUP), 0.01)
    w_gate = nrm(ks[20], (DEPTH, N_EXPERTS, D_MODEL, D_FF_EXPERT), D_MODEL ** -0.5)
    w_up = nrm(ks[21], (DEPTH, N_EXPERTS, D_MODEL, D_FF_EXPERT), D_MODEL ** -0.5)
    w_down = nrm(ks[22], (DEPTH, N_EXPERTS, D_FF_EXPERT, D_MODEL), D_FF_EXPERT ** -0.5 * BETA)
    ln2_g = 1.0 + nrm(ks[23], (DEPTH, D_MODEL), 0.02)
    ln2_b = nrm(ks[24], (DEPTH, D_MODEL), 0.01)
    return {'x': x, 'meta_tokens': meta_tokens, 'w_in': w_in, 'conv_w': conv_w, 'conv_b': conv_b,
            'lru_wa': lru_wa, 'lru_ba': lru_ba, 'lru_wx': lru_wx, 'lru_bx': lru_bx,
            'lru_lambda': lru_lambda, 'attn_sinks': attn_sinks, 'g_attn': g_attn, 'g_lru': g_lru,
            'w_out': w_out, 'ln1_g': ln1_g, 'ln1_b': ln1_b, 'w_group': w_group, 'b_group': b_group,
            'w_router': w_router, 'b_router': b_router, 'w_gate': w_gate, 'w_up': w_up,
            'w_down': w_down, 'ln2_g': ln2_g, 'ln2_b': ln2_b}


def reference(x, meta_tokens, w_in, conv_w, conv_b, lru_wa, lru_ba, lru_wx, lru_bx, lru_lambda,
              attn_sinks, g_attn, g_lru, w_out, ln1_g, ln1_b, w_group, b_group, w_router,
              b_router, w_gate, w_up, w_down, ln2_g, ln2_b):
    bsz = x.shape[0]
    meta = jnp.broadcast_to(meta_tokens[None].astype(x.dtype), (bsz, N_META, D_MODEL))
    h = jnp.concatenate([meta, x], axis=1)
    for l in range(DEPTH):
        mix = token_mixer(h, w_in[l], conv_w[l], conv_b[l], lru_wa[l], lru_ba[l], lru_wx[l],
                          lru_bx[l], lru_lambda[l], attn_sinks[l], g_attn[l], g_lru[l], w_out[l])
        h = layer_norm(ALPHA * h + mix, ln1_g[l], ln1_b[l])
        ff = hierarchical_moe(h, w_group[l], b_group[l], w_router[l], b_router[l],
                              w_gate[l], w_up[l], w_down[l])
        h = layer_norm(ALPHA * h + ff, ln2_g[l], ln2_b[l])
    return h[:, N_META:]
```

```cpp
#include <hip/hip_runtime.h>
#include <cstdio>
#include <cstdint>

#define GAS __attribute__((address_space(1)))
#define LAS __attribute__((address_space(3)))
typedef unsigned short bf16;
typedef float f32x4 __attribute__((ext_vector_type(4)));
typedef unsigned v4u __attribute__((ext_vector_type(4)));
typedef GAS unsigned gu32;
#define RLX_AGENT __ATOMIC_RELAXED, __HIP_MEMORY_SCOPE_AGENT

#ifndef ONE_LAUNCH
#define ONE_LAUNCH 1
#endif

constexpr int NB = 4, SEQ = 4096, DM = 1024, NMETA = 16;
constexpr int NTOK = NB * SEQ;
constexpr int NROW = NTOK + NMETA;
constexpr int AW = 512, LW = 512, KVW = 128, HD = 64, NQH = 8;
constexpr int INC = 1792;
constexpr int NEXP = 32, EPG = 8, NGRP = 4, DFF = 512;
constexpr int NSLOT = NTOK * 2;
constexpr float ALPHA = 1.189207115002721f;
constexpr float EPS = 1e-5f;
constexpr int NWAVES = 8, NTHR = 512;

constexpr size_t MiB = 1u << 20;
constexpr size_t WS_CTL = 0, CTL_ZERO_BYTES = 1 * MiB;
constexpr size_t WS_LIST = 1 * MiB;
constexpr size_t WS_GATE = 3 * MiB;
constexpr size_t WS_Q    = 4 * MiB;
constexpr size_t WS_K    = 21 * MiB;
constexpr size_t WS_V    = 26 * MiB;
constexpr size_t WS_XR   = 31 * MiB;
constexpr size_t WS_GY   = 48 * MiB;
constexpr size_t WS_MRG  = 65 * MiB;
constexpr size_t WS_H1B  = 97 * MiB;
constexpr size_t WS_Z    = 129 * MiB;
constexpr size_t WS_HID  = 129 * MiB;
constexpr size_t WS_YB   = 193 * MiB;
constexpr size_t WS_ATT  = 194 * MiB;
constexpr size_t WS_HL   = 226 * MiB;
constexpr size_t WS_AU   = 129 * MiB;
constexpr size_t WS_END  = 258 * MiB;
constexpr int CW_CNT = 64;
constexpr int CW_BAR = 4096;

constexpr int LDS_BYTES = 147456;
constexpr int MISC_OFF = 131072 + 320;

__device__ __forceinline__ unsigned f2bf(float f) { unsigned u = __builtin_bit_cast(unsigned, f); return (u + 0x7fffu + ((u >> 16) & 1u)) >> 16; }
__device__ __forceinline__ float bf2f(bf16 h) { return __builtin_bit_cast(float, (unsigned)h << 16); }
__device__ __forceinline__ float wave_sum(float v) {
#pragma unroll
    for (int o = 1; o < 64; o <<= 1) v += __shfl_xor(v, o);
    return v;
}
__device__ __forceinline__ float wave_max(float v) {
#pragma unroll
    for (int o = 1; o < 64; o <<= 1) v = fmaxf(v, __shfl_xor(v, o));
    return v;
}
__device__ __forceinline__ float sigmoidf_(float x) { return 1.f / (1.f + __expf(-x)); }
__device__ __forceinline__ float gelu_tanh(float y) { const float t = 0.7978845608028654f * (y + 0.044715f * y * y * y); return 0.5f * y * (1.f + tanhf(t)); }

#define XB_TMO      128
#define XB_XCNT(j)  (256  + 64 * (j))
#define XB_XSUB(j)  (1280 + 64 * (j))
#define XB_XGEN(j)  (2304 + 64 * (j))
#define XB_TOP      3328
#define XB_TOPGEN   3392
#define XCD_BAR_WORDS 3456
#define XB_SPIN_CAP (1u << 18)
__device__ __forceinline__ unsigned xb_ld(unsigned* p)              { return __hip_atomic_load(p, __ATOMIC_RELAXED, __HIP_MEMORY_SCOPE_AGENT); }
__device__ __forceinline__ unsigned xb_add(unsigned* p, unsigned v) { return __hip_atomic_fetch_add(p, v, __ATOMIC_RELAXED, __HIP_MEMORY_SCOPE_AGENT); }
__device__ __forceinline__ unsigned xb_xcc_id() { return (unsigned)__builtin_amdgcn_s_getreg((3 << 11) | 20) & 0xFu; }
#define XB_SPIN(cond, bar) do { unsigned _sp = 0; while (cond) { __builtin_amdgcn_s_sleep(1); \
    if ((++_sp & 255u) == 0u) { if (xb_ld(&(bar)[XB_TMO])) break; if (_sp > XB_SPIN_CAP) { atomicAdd(&(bar)[XB_TMO], 1u); break; } } } } while (0)
struct XcdBarrier { unsigned* bar; unsigned x; volatile LAS unsigned* st; };
__device__ __forceinline__ XcdBarrier xcd_barrier_post(unsigned* bar, volatile LAS unsigned* st) {
    XcdBarrier b; b.bar = bar; b.x = xb_xcc_id(); b.st = st;
    if (threadIdx.x == 0) (void)xb_add(&bar[XB_XCNT(b.x)], 1u);
    return b;
}
__device__ __forceinline__ void xcd_barrier_complete(unsigned* bar, unsigned x, unsigned& nloc, unsigned& nx) {
    const unsigned G = gridDim.x * gridDim.y * gridDim.z;
    unsigned sum, cnt, mine, sp = 0u;
    for (;;) {
        sum = 0u; cnt = 0u; mine = 0u;
#pragma unroll
        for (unsigned j = 0; j < 16; ++j) { const unsigned c = xb_ld(&bar[XB_XCNT(j)]); sum += c; cnt += (c > 0u) ? 1u : 0u; mine = (j == x) ? c : mine; }
        if (sum == G) break;
        __builtin_amdgcn_s_sleep(1);
        if ((++sp & 255u) == 0u) { if (xb_ld(&bar[XB_TMO])) break; if (sp > XB_SPIN_CAP) { atomicAdd(&bar[XB_TMO], 1u); break; } }
    }
    nloc = mine > 0u ? mine : 1u; nx = cnt > 0u ? cnt : 1u;
}
__device__ __forceinline__ void xcd_barrier(const XcdBarrier& b) {
    asm volatile("s_waitcnt vmcnt(0)" ::: "memory");
    __syncthreads();
    if (threadIdx.x == 0) {
        unsigned* bar = b.bar;
        __builtin_amdgcn_s_waitcnt(0);
        unsigned nloc = b.st[0], nx = b.st[1];
        if (nloc == 0u) { xcd_barrier_complete(bar, b.x, nloc, nx); b.st[0] = nloc; b.st[1] = nx; }
        const unsigned old = xb_add(&bar[XB_XSUB(b.x)], 1u);
        const unsigned gen = old / nloc;
        if (old + 1u == (gen + 1u) * nloc) {
            __builtin_amdgcn_fence(__ATOMIC_RELEASE, "agent");
            asm volatile("s_waitcnt vmcnt(0)" ::: "memory");
            const unsigned og = xb_add(&bar[XB_TOP], 1u);
            const unsigned tg = og / nx;
            if (og + 1u == (tg + 1u) * nx) xb_add(&bar[XB_TOPGEN], 1u);
            else XB_SPIN(xb_ld(&bar[XB_TOPGEN]) == tg, bar);
            __builtin_amdgcn_fence(__ATOMIC_ACQUIRE, "agent");
            xb_add(&bar[XB_XGEN(b.x)], 1u);
            asm volatile("s_waitcnt vmcnt(0)" ::: "memory");
        } else {
            XB_SPIN(xb_ld(&bar[XB_XGEN(b.x)]) == gen, bar);
            __builtin_amdgcn_fence(__ATOMIC_ACQUIRE, "agent");
            asm volatile("s_waitcnt vmcnt(0)" ::: "memory");
        }
    }
    __syncthreads();
}

struct Args {
    const float* in[25]; float* out; unsigned char* ws; int ph_lo, ph_hi;
};
struct Frame {
    LAS unsigned char* lds;
    int tid, lane, wave, G, bid;
    const float *x, *meta, *w_in, *conv_w, *conv_b, *wa, *ba, *wx, *bx, *lam, *sinks, *g_attn, *g_lru, *w_out, *ln1g, *ln1b,
                *w_group, *b_group, *w_router, *b_router, *w_gate, *w_up, *w_down, *ln2g, *ln2b;
    float* out;
    unsigned char* ws;
    unsigned* ctl;
};

template <class AF, class BF>
__device__ __forceinline__ void ngemm_tile(LAS float* sm, int K, AF af, BF bf, float (&acc)[4][4], int tid) {
    LAS float* As = sm;
    LAS float* Bs = sm + 16 * 68;
    const int ty = tid >> 5, tx = tid & 31;
#pragma unroll
    for (int i = 0; i < 4; ++i)
#pragma unroll
        for (int j = 0; j < 4; ++j) acc[i][j] = 0.f;
    for (int k0 = 0; k0 < K; k0 += 16) {
        float av[2], bv[4];
#pragma unroll
        for (int i = 0; i < 2; ++i) { const int e = tid + i * 512; av[i] = af(e >> 4, k0 + (e & 15)); }
#pragma unroll
        for (int i = 0; i < 4; ++i) { const int e = tid + i * 512; bv[i] = bf(k0 + (e >> 7), e & 127); }
        __syncthreads();
#pragma unroll
        for (int i = 0; i < 2; ++i) { const int e = tid + i * 512; As[(e & 15) * 68 + (e >> 4)] = av[i]; }
#pragma unroll
        for (int i = 0; i < 4; ++i) { const int e = tid + i * 512; Bs[(e >> 7) * 128 + (e & 127)] = bv[i]; }
        __syncthreads();
#pragma unroll
        for (int kk = 0; kk < 16; ++kk) {
            const f32x4 a = *(const LAS f32x4*)(As + kk * 68 + ty * 4);
            const f32x4 b = *(const LAS f32x4*)(Bs + kk * 128 + tx * 4);
#pragma unroll
            for (int i = 0; i < 4; ++i)
#pragma unroll
                for (int j = 0; j < 4; ++j) acc[i][j] += a[i] * b[j];
        }
    }
    __syncthreads();
}

__device__ __forceinline__ void ph_inproj_naive(Frame& F) {
    LAS float* sm = (LAS float*)F.lds;
    constexpr int NRT = (NROW + 63) / 64, NCT = INC / 128;
    bf16* Q = (bf16*)(F.ws + WS_Q); bf16* Kb = (bf16*)(F.ws + WS_K); bf16* Vb = (bf16*)(F.ws + WS_V); bf16* XR = (bf16*)(F.ws + WS_XR); bf16* GY = (bf16*)(F.ws + WS_GY);
    for (int t = F.bid; t < NRT * NCT; t += F.G) {
        const int rt = t / NCT, ct = t % NCT, r0 = rt * 64, c0 = ct * 128;
        const float* x = F.x; const float* meta = F.meta; const float* w = F.w_in;
        float acc[4][4];
        ngemm_tile(sm, DM,
            [&](int r, int k) -> float { const int row = r0 + r; if (row >= NROW) return 0.f; return row < NTOK ? x[(size_t)row * DM + k] : meta[(size_t)(row - NTOK) * DM + k]; },
            [&](int k, int c) -> float { return w[(size_t)k * INC + c0 + c]; }, acc, F.tid);
        const int ty = F.tid >> 5, tx = F.tid & 31;
#pragma unroll
        for (int i = 0; i < 4; ++i) {
            const int row = r0 + ty * 4 + i; if (row >= NROW) continue;
#pragma unroll
            for (int j = 0; j < 4; ++j) {
                const int c = c0 + tx * 4 + j; const float v = acc[i][j];
                if (c < 512) Q[(size_t)row * 512 + c] = (bf16)f2bf(v);
                else if (c < 640) Kb[(size_t)row * 128 + (c - 512)] = (bf16)f2bf(v);
                else if (c < 768) Vb[(size_t)row * 128 + (c - 640)] = (bf16)f2bf(v);
                else if (c < 1280) XR[(size_t)row * 512 + (c - 768)] = (bf16)f2bf(v);
                else GY[(size_t)row * 512 + (c - 1280)] = (bf16)f2bf(gelu_tanh(v));
            }
        }
    }
}

__device__ __forceinline__ void ph_attn_naive(Frame& F) {
    const bf16* Q = (const bf16*)(F.ws + WS_Q); const bf16* Kb = (const bf16*)(F.ws + WS_K); const bf16* Vb = (const bf16*)(F.ws + WS_V);
    float* ATT = (float*)(F.ws + WS_ATT);
    const int gw = F.bid * NWAVES + F.wave, NGW = F.G * NWAVES, lane = F.lane;
    for (int it = gw; it < NTOK * NQH; it += NGW) {
        const int row = it >> 3, hq = it & 7, kvh = hq >> 2, b = row >> 12, s = row & 4095;
        const float slope = exp2f(-(float)(hq + 1)), sink = F.sinks[hq];
        const bf16* q = Q + (size_t)row * 512 + hq * 64;
        float lg[2]; int krow[2];
#pragma unroll
        for (int h = 0; h < 2; ++h) {
            const int o = lane + 64 * h, tt = s + 16 - o;
            krow[h] = -1; lg[h] = -1e30f;
            if (tt >= 0) {
                krow[h] = tt >= 16 ? b * SEQ + (tt - 16) : NTOK + tt;
                const bf16* k = Kb + (size_t)krow[h] * 128 + kvh * 64;
                float d = 0.f;
                for (int c = 0; c < 64; ++c) d += bf2f(q[c]) * bf2f(k[c]);
                lg[h] = d * 0.125f - slope * (float)o;
            }
        }
        const float m = fmaxf(wave_max(fmaxf(lg[0], lg[1])), sink);
        float p0 = krow[0] >= 0 ? __expf(lg[0] - m) : 0.f, p1 = krow[1] >= 0 ? __expf(lg[1] - m) : 0.f;
        const float den = wave_sum(p0 + p1) + __expf(sink - m);
        float o_acc = 0.f;
        for (int o = 0; o < 128; ++o) {
            const float p = __shfl(o < 64 ? p0 : p1, o & 63);
            const int kr = __shfl(o < 64 ? krow[0] : krow[1], o & 63);
            if (kr >= 0) o_acc += p * bf2f(Vb[(size_t)kr * 128 + kvh * 64 + lane]);
        }
        ATT[(size_t)row * 512 + hq * 64 + lane] = o_acc / den;
    }
}

__device__ __forceinline__ float xr_at(const bf16* XR, int b, int tt, int ch) {
    if (tt < 0) return 0.f;
    const int row = tt >= 16 ? b * SEQ + (tt - 16) : NTOK + tt;
    return bf2f(XR[(size_t)row * 512 + ch]);
}
__device__ __forceinline__ void ph_gates_naive(Frame& F) {
    const bf16* XR = (const bf16*)(F.ws + WS_XR);
    float* A_ = (float*)(F.ws + WS_AU); float* U_ = A_ + (size_t)NROW * 512;
    const int gt = F.bid * NTHR + F.tid, NGT = F.G * NTHR;
    for (int it = gt; it < NROW * 512; it += NGT) {
        const int row = it >> 9, ch = it & 511, n = ch >> 6, d = ch & 63;
        int b, tt; if (row < NTOK) { b = row >> 12; tt = (row & 4095) + 16; } else { b = 0; tt = row - NTOK; }
        float rp = F.ba[ch], ip = F.bx[ch], xcd = 0.f;
        for (int c = 0; c < 64; ++c) {
            const int cc = n * 64 + c;
            float xc = F.conv_b[cc];
#pragma unroll
            for (int k = 0; k < 4; ++k) xc += F.conv_w[k * 512 + cc] * xr_at(XR, b, tt - 3 + k, cc);
            rp += xc * F.wa[(n * 64 + c) * 64 + d]; ip += xc * F.wx[(n * 64 + c) * 64 + d];
            if (c == d) xcd = xc;
        }
        const float r = sigmoidf_(rp), ig = sigmoidf_(ip);
        const float nl = -F.lam[ch], sp = fmaxf(nl, 0.f) + log1pf(__expf(-fabsf(nl)));
        const float log_a = -8.0f * r * sp, a = __expf(log_a);
        const float u = sqrtf(fmaxf(-expm1f(2.f * log_a), 0.f)) * (ig * xcd);
        A_[it] = a; U_[it] = u;
    }
}
__device__ __forceinline__ void ph_scan_naive(Frame& F) {
    const float* A_ = (const float*)(F.ws + WS_AU); const float* U_ = A_ + (size_t)NROW * 512;
    float* HL = (float*)(F.ws + WS_HL);
    const int gt = F.bid * NTHR + F.tid;
    if (gt < NB * 512) {
        const int b = gt >> 9, ch = gt & 511; float h = 0.f;
        for (int m = 0; m < NMETA; ++m) { const size_t i = (size_t)(NTOK + m) * 512 + ch; h = A_[i] * h + U_[i]; }
        for (int s = 0; s < SEQ; ++s) { const size_t i = (size_t)(b * SEQ + s) * 512 + ch; h = A_[i] * h + U_[i]; HL[i] = h; }
    }
}
__device__ __forceinline__ void ph_merge_naive(Frame& F) {
    const float* ATT = (const float*)(F.ws + WS_ATT); const float* HL = (const float*)(F.ws + WS_HL); const bf16* GY = (const bf16*)(F.ws + WS_GY);
    bf16* MRG = (bf16*)(F.ws + WS_MRG);
    const int gw = F.bid * NWAVES + F.wave, NGW = F.G * NWAVES, lane = F.lane;
    for (int row = gw; row < NTOK; row += NGW) {
        float a[8], l[8], sa = 0.f, sl = 0.f;
#pragma unroll
        for (int j = 0; j < 8; ++j) { const int c = lane + 64 * j; a[j] = ATT[(size_t)row * 512 + c]; l[j] = HL[(size_t)row * 512 + c] * bf2f(GY[(size_t)row * 512 + c]); sa += a[j] * a[j]; sl += l[j] * l[j]; }
        const float ra = 1.f / sqrtf(wave_sum(sa) * (1.f / 512.f) + EPS), rl = 1.f / sqrtf(wave_sum(sl) * (1.f / 512.f) + EPS);
#pragma unroll
        for (int j = 0; j < 8; ++j) { const int c = lane + 64 * j;
            MRG[(size_t)row * 1024 + c] = (bf16)f2bf(a[j] * ra * F.g_attn[c]); MRG[(size_t)row * 1024 + 512 + c] = (bf16)f2bf(l[j] * rl * F.g_lru[c]); }
    }
}
__device__ __forceinline__ void ph_outproj_naive(Frame& F) {
    LAS float* sm = (LAS float*)F.lds;
    const bf16* MRG = (const bf16*)(F.ws + WS_MRG); float* Z = (float*)(F.ws + WS_Z);
    constexpr int NRT = NTOK / 64, NCT = DM / 128;
    for (int t = F.bid; t < NRT * NCT; t += F.G) {
        const int rt = t / NCT, ct = t % NCT, r0 = rt * 64, c0 = ct * 128; const float* w = F.w_out;
        float acc[4][4];
        ngemm_tile(sm, DM, [&](int r, int k) -> float { return bf2f(MRG[(size_t)(r0 + r) * 1024 + k]); },
                            [&](int k, int c) -> float { return w[(size_t)k * DM + c0 + c]; }, acc, F.tid);
        const int ty = F.tid >> 5, tx = F.tid & 31;
#pragma unroll
        for (int i = 0; i < 4; ++i) { const int row = r0 + ty * 4 + i;
#pragma unroll
            for (int j = 0; j < 4; ++j) { const int c = c0 + tx * 4 + j; Z[(size_t)row * DM + c] = ALPHA * F.x[(size_t)row * DM + c] + acc[i][j]; } }
    }
}
__device__ __forceinline__ void ph_router(Frame& F) {
    const float* Z = (const float*)(F.ws + WS_Z); bf16* H1B = (bf16*)(F.ws + WS_H1B);
    int* LIST = (int*)(F.ws + WS_LIST); float* GATE = (float*)(F.ws + WS_GATE); unsigned* cnt = F.ctl + CW_CNT;
    const int gw = F.bid * NWAVES + F.wave, NGW = F.G * NWAVES, lane = F.lane;
    for (int row = gw; row < NTOK; row += NGW) {
        float v[16]; float s = 0.f;
#pragma unroll
        for (int j = 0; j < 16; ++j) { v[j] = Z[(size_t)row * DM + lane + 64 * j]; s += v[j]; }
        const float mu = wave_sum(s) * (1.f / DM); float q = 0.f;
#pragma unroll
        for (int j = 0; j < 16; ++j) { v[j] -= mu; q += v[j] * v[j]; }
        const float rstd = 1.f / sqrtf(wave_sum(q) * (1.f / DM) + EPS);
#pragma unroll
        for (int j = 0; j < 16; ++j) { const int c = lane + 64 * j; v[j] = v[j] * rstd * F.ln1g[c] + F.ln1b[c]; H1B[(size_t)row * DM + c] = (bf16)f2bf(v[j]); }
        float gl[4];
#pragma unroll
        for (int g = 0; g < 4; ++g) { float p = 0.f;
#pragma unroll
            for (int j = 0; j < 16; ++j) p += v[j] * F.w_group[(size_t)(lane + 64 * j) * 4 + g];
            gl[g] = wave_sum(p) + F.b_group[g]; }
        int gi = 0; float gm = gl[0];
#pragma unroll
        for (int g = 1; g < 4; ++g) if (gl[g] > gm) { gm = gl[g]; gi = g; }
        float gs = 0.f;
#pragma unroll
        for (int g = 0; g < 4; ++g) gs += __expf(gl[g] - gm);
        const float gw_ = 1.f / gs;
        float el[8];
#pragma unroll
        for (int e = 0; e < 8; ++e) { float p = 0.f;
#pragma unroll
            for (int j = 0; j < 16; ++j) p += v[j] * F.w_router[((size_t)gi * DM + lane + 64 * j) * 8 + e];
            el[e] = wave_sum(p) + F.b_router[gi * 8 + e]; }
        int i1 = 0; float v1 = el[0];
#pragma unroll
        for (int e = 1; e < 8; ++e) if (el[e] > v1) { v1 = el[e]; i1 = e; }
        int i2 = -1; float v2 = -3.0e38f;
#pragma unroll
        for (int e = 0; e < 8; ++e) if (e != i1 && el[e] > v2) { v2 = el[e]; i2 = e; }
        const float e2 = __expf(v2 - v1), w1 = gw_ / (1.f + e2), w2 = gw_ * e2 / (1.f + e2);
        if (lane < 2) {
            const int e = gi * 8 + (lane == 0 ? i1 : i2); const int slot = row * 2 + lane;
            const unsigned pos = __hip_atomic_fetch_add(cnt + e, 1u, RLX_AGENT);
            LIST[(size_t)e * NTOK + pos] = slot; GATE[slot] = lane == 0 ? w1 : w2;
        }
    }
}
__device__ __forceinline__ void moe_find(const unsigned* cnt, int tile_rows, int t, int& e, int& rt, int& p256, int& n) {
    int acc = 0, pad = 0; e = -1; rt = 0; p256 = 0; n = 0;
    for (int i = 0; i < NEXP; ++i) { const int c = (int)cnt[i], nt = (c + tile_rows - 1) / tile_rows;
        if (e < 0 && t < acc + nt) { e = i; rt = t - acc; p256 = pad; n = c; }
        acc += nt; pad += (c + 255) / 256 * 256; }
}
__device__ __forceinline__ int moe_total(const unsigned* cnt, int tile_rows) { int acc = 0; for (int i = 0; i < NEXP; ++i) acc += ((int)cnt[i] + tile_rows - 1) / tile_rows; return acc; }

__device__ __forceinline__ void ph_moe1_naive(Frame& F) {
    LAS float* sm = (LAS float*)F.lds;
    const bf16* H1B = (const bf16*)(F.ws + WS_H1B); const int* LIST = (const int*)(F.ws + WS_LIST); bf16* HID = (bf16*)(F.ws + WS_HID);
    const unsigned* cnt = F.ctl + CW_CNT;
    const int ntile = moe_total(cnt, 64);
    for (int t = F.bid; t < ntile * 4; t += F.G) {
        const int ct = t & 3; int e, rt, p256, n; moe_find(cnt, 64, t >> 2, e, rt, p256, n);
        const int* lst = LIST + (size_t)e * NTOK + rt * 64; const int nrow = n - rt * 64;
        const float* wg = F.w_gate + (size_t)e * DM * DFF + ct * 128; const float* wu = F.w_up + (size_t)e * DM * DFF + ct * 128;
        float ag[4][4], au[4][4];
        auto af = [&](int r, int k) -> float { const int tok = (r < nrow ? lst[r] : lst[0]) >> 1; return bf2f(H1B[(size_t)tok * DM + k]); };
        ngemm_tile(sm, DM, af, [&](int k, int c) -> float { return wg[(size_t)k * DFF + c]; }, ag, F.tid);
        ngemm_tile(sm, DM, af, [&](int k, int c) -> float { return wu[(size_t)k * DFF + c]; }, au, F.tid);
        const int ty = F.tid >> 5, tx = F.tid & 31;
#pragma unroll
        for (int i = 0; i < 4; ++i) { const int r = ty * 4 + i; if (r >= nrow) continue;
#pragma unroll
            for (int j = 0; j < 4; ++j) { const float g = ag[i][j]; HID[(size_t)(p256 + rt * 64 + r) * DFF + ct * 128 + tx * 4 + j] = (bf16)f2bf(g * sigmoidf_(g) * au[i][j]); } }
    }
}
__device__ __forceinline__ void ph_moe2_naive(Frame& F) {
    LAS float* sm = (LAS float*)F.lds;
    const int* LIST = (const int*)(F.ws + WS_LIST); const float* GATE = (const float*)(F.ws + WS_GATE); const bf16* HID = (const bf16*)(F.ws + WS_HID); bf16* YB = (bf16*)(F.ws + WS_YB);
    const unsigned* cnt = F.ctl + CW_CNT;
    const int ntile = moe_total(cnt, 64);
    for (int t = F.bid; t < ntile * 8; t += F.G) {
        const int ct = t & 7; int e, rt, p256, n; moe_find(cnt, 64, t >> 3, e, rt, p256, n);
        const int* lst = LIST + (size_t)e * NTOK + rt * 64; const int nrow = n - rt * 64;
        const float* wd = F.w_down + (size_t)e * DFF * DM + ct * 128; const bf16* hid = HID + (size_t)(p256 + rt * 64) * DFF;
        float acc[4][4];
        ngemm_tile(sm, DFF, [&](int r, int k) -> float { return r < nrow ? bf2f(hid[(size_t)r * DFF + k]) : 0.f; },
                             [&](int k, int c) -> float { return wd[(size_t)k * DM + c]; }, acc, F.tid);
        const int ty = F.tid >> 5, tx = F.tid & 31;
#pragma unroll
        for (int i = 0; i < 4; ++i) { const int r = ty * 4 + i; if (r >= nrow) continue; const int slot = lst[r]; const float g = GATE[slot];
#pragma unroll
            for (int j = 0; j < 4; ++j) YB[(size_t)slot * DM + ct * 128 + tx * 4 + j] = (bf16)f2bf(g * acc[i][j]); }
    }
}
__device__ __forceinline__ void ph_ln2(Frame& F) {
    const bf16* H1B = (const bf16*)(F.ws + WS_H1B); const bf16* YB = (const bf16*)(F.ws + WS_YB);
    const int gw = F.bid * NWAVES + F.wave, NGW = F.G * NWAVES, lane = F.lane;
    for (int row = gw; row < NTOK; row += NGW) {
        float v[16]; float s = 0.f;
#pragma unroll
        for (int j = 0; j < 16; ++j) { const int c = lane + 64 * j;
            v[j] = ALPHA * bf2f(H1B[(size_t)row * DM + c]) + bf2f(YB[(size_t)(2 * row) * DM + c]) + bf2f(YB[(size_t)(2 * row + 1) * DM + c]); s += v[j]; }
        const float mu = wave_sum(s) * (1.f / DM); float q = 0.f;
#pragma unroll
        for (int j = 0; j < 16; ++j) { v[j] -= mu; q += v[j] * v[j]; }
        const float rstd = 1.f / sqrtf(wave_sum(q) * (1.f / DM) + EPS);
#pragma unroll
        for (int j = 0; j < 16; ++j) { const int c = lane + 64 * j; F.out[(size_t)row * DM + c] = v[j] * rstd * F.ln2g[c] + F.ln2b[c]; }
    }
}

constexpr int N_PHASES = 10;
__global__ void __launch_bounds__(NTHR, 2) hymba_fwd(Args args) {
    extern __shared__ __attribute__((aligned(16))) unsigned char lds[];
    Frame F;
    F.lds = (LAS unsigned char*)lds;
    F.tid = threadIdx.x; F.lane = F.tid & 63; F.wave = __builtin_amdgcn_readfirstlane(F.tid >> 6); F.G = gridDim.x; F.bid = blockIdx.x;
    F.x = args.in[0]; F.meta = args.in[1]; F.w_in = args.in[2]; F.conv_w = args.in[3]; F.conv_b = args.in[4]; F.wa = args.in[5]; F.ba = args.in[6]; F.wx = args.in[7]; F.bx = args.in[8];
    F.lam = args.in[9]; F.sinks = args.in[10]; F.g_attn = args.in[11]; F.g_lru = args.in[12]; F.w_out = args.in[13]; F.ln1g = args.in[14]; F.ln1b = args.in[15];
    F.w_group = args.in[16]; F.b_group = args.in[17]; F.w_router = args.in[18]; F.b_router = args.in[19]; F.w_gate = args.in[20]; F.w_up = args.in[21]; F.w_down = args.in[22];
    F.ln2g = args.in[23]; F.ln2b = args.in[24]; F.out = args.out; F.ws = args.ws; F.ctl = (unsigned*)(args.ws + WS_CTL);
    volatile LAS unsigned* MISC = (volatile LAS unsigned*)(F.lds + MISC_OFF);
    if (F.tid < 32) MISC[F.tid] = 0u;
    __syncthreads();
    XcdBarrier bar; bar.bar = F.ctl + CW_BAR; bar.x = 0; bar.st = nullptr;
    const int lo = args.ph_lo, hi = args.ph_hi;
    if (hi - lo > 1) bar = xcd_barrier_post(F.ctl + CW_BAR, MISC + 8);
#define IN(k) (lo <= (k) && (k) < hi)
#define SEAM(k) do { if (IN(k) && IN((k) + 1)) xcd_barrier(bar); } while (0)
    if (IN(0)) ph_inproj_naive(F);  SEAM(0);
    if (IN(1)) ph_attn_naive(F);    SEAM(1);
    if (IN(2)) ph_gates_naive(F);   SEAM(2);
    if (IN(3)) ph_scan_naive(F);    SEAM(3);
    if (IN(4)) ph_merge_naive(F);   SEAM(4);
    if (IN(5)) ph_outproj_naive(F); SEAM(5);
    if (IN(6)) ph_router(F);        SEAM(6);
    if (IN(7)) ph_moe1_naive(F);    SEAM(7);
    if (IN(8)) ph_moe2_naive(F);    SEAM(8);
    if (IN(9)) ph_ln2(F);
#undef IN
#undef SEAM
}

extern "C" void kernel_launch(void* const* d_in, const int* in_sizes, int n_in, void* d_out, int out_size, void* d_ws, size_t ws_size, hipStream_t stream) {
    static int grid = 0;
    if (grid == 0) {
        if (n_in != 25 || in_sizes[0] != NTOK * DM || out_size != NTOK * DM || ws_size < WS_END) {
            fprintf(stderr, "kernel_launch: unexpected shapes: n_in %d in0 %d out %d ws %zu (need %zu)\n", n_in, n_in > 0 ? in_sizes[0] : -1, out_size, ws_size, (size_t)WS_END); grid = -1; return; }
        int dev = 0, cus = 0, per_cu = 0;
        if (hipGetDevice(&dev) != hipSuccess || hipDeviceGetAttribute(&cus, hipDeviceAttributeMultiprocessorCount, dev) != hipSuccess) { grid = -1; return; }
        if (hipFuncSetAttribute((const void*)hymba_fwd, hipFuncAttributeMaxDynamicSharedMemorySize, LDS_BYTES) != hipSuccess) { fprintf(stderr, "kernel_launch: hipFuncSetAttribute failed\n"); grid = -1; return; }
        if (hipOccupancyMaxActiveBlocksPerMultiprocessor(&per_cu, (const void*)hymba_fwd, NTHR, LDS_BYTES) != hipSuccess || per_cu < 1) { fprintf(stderr, "kernel_launch: occupancy query says %d\n", per_cu); per_cu = 1; }
        (void)hipGetLastError();
        grid = cus;
    }
    if (grid < 0) return;
    (void)hipMemsetAsync((char*)d_ws + WS_CTL, 0, CTL_ZERO_BYTES, stream);
    Args a{};
    for (int i = 0; i < 25; ++i) a.in[i] = (const float*)d_in[i];
    a.out = (float*)d_out; a.ws = (unsigned char*)d_ws;
#if ONE_LAUNCH
    a.ph_lo = 0; a.ph_hi = N_PHASES;
    hipLaunchKernelGGL(hymba_fwd, dim3(grid), dim3(NTHR), LDS_BYTES, stream, a);
#else
    for (int p = 0; p < N_PHASES; ++p) { a.ph_lo = p; a.ph_hi = p + 1; hipLaunchKernelGGL(hymba_fwd, dim3(grid), dim3(NTHR), LDS_BYTES, stream, a); }
#endif
}
```

```cpp
#include <hip/hip_runtime.h>
#include <cstdio>
#include <cstdint>

#define GAS __attribute__((address_space(1)))
#define LAS __attribute__((address_space(3)))
typedef unsigned short bf16;
typedef float f32x4 __attribute__((ext_vector_type(4)));
typedef unsigned v4u __attribute__((ext_vector_type(4)));
typedef GAS unsigned gu32;
#define RLX_AGENT __ATOMIC_RELAXED, __HIP_MEMORY_SCOPE_AGENT

#ifndef ONE_LAUNCH
#define ONE_LAUNCH 1
#endif

constexpr int NB = 4, SEQ = 4096, DM = 1024, NMETA = 16;
constexpr int NTOK = NB * SEQ;
constexpr int NROW = NTOK + NMETA;
constexpr int AW = 512, LW = 512, KVW = 128, HD = 64, NQH = 8;
constexpr int INC = 1792;
constexpr int NEXP = 32, EPG = 8, NGRP = 4, DFF = 512;
constexpr int NSLOT = NTOK * 2;
constexpr float ALPHA = 1.189207115002721f;
constexpr float EPS = 1e-5f;
constexpr int NWAVES = 8, NTHR = 512;

constexpr size_t MiB = 1u << 20;
constexpr size_t WS_CTL = 0, CTL_ZERO_BYTES = 1 * MiB;
constexpr size_t WS_LIST = 1 * MiB;
constexpr size_t WS_GATE = 3 * MiB;
constexpr size_t WS_WINT = 4 * MiB;
constexpr size_t WS_WOUTT = 8 * MiB;
constexpr size_t WS_XB   = 10 * MiB;
constexpr size_t WS_AU_A = 10 * MiB;
constexpr size_t WS_Q    = 43 * MiB;
constexpr size_t WS_K    = 59 * MiB;
constexpr size_t WS_V    = 64 * MiB;
constexpr size_t WS_XR   = 69 * MiB;
constexpr size_t WS_GY   = 86 * MiB;
constexpr size_t WS_MRG  = 102 * MiB;
constexpr size_t WS_H1B  = 134 * MiB;
constexpr size_t WS_Z    = 166 * MiB;
constexpr size_t WS_HID  = 166 * MiB;
constexpr size_t WS_ATT  = 166 * MiB;
constexpr size_t WS_HL   = 198 * MiB;
constexpr size_t WS_AU_U = 230 * MiB;
constexpr size_t WS_WGUT = 10 * MiB;
constexpr size_t WS_WDT  = 74 * MiB;
constexpr size_t WS_YB   = 10 * MiB;
constexpr size_t WS_HLOC = 10 * MiB;
constexpr size_t WS_PCUM = 26 * MiB;
constexpr size_t WS_AGG  = 230 * MiB;
constexpr size_t WS_GWT  = 232 * MiB;
constexpr size_t WS_END  = 263 * MiB;
constexpr int CW_CNT = 64;
constexpr int CW_BAR = 4096;

constexpr int LDS_BYTES = 147456;
constexpr int MISC_OFF = 143360;

__device__ __forceinline__ unsigned f2bf(float f) { unsigned u = __builtin_bit_cast(unsigned, f); return (u + 0x7fffu + ((u >> 16) & 1u)) >> 16; }
__device__ __forceinline__ float bf2f(bf16 h) { return __builtin_bit_cast(float, (unsigned)h << 16); }
__device__ __forceinline__ float wave_sum(float v) {
#pragma unroll
    for (int o = 1; o < 64; o <<= 1) v += __shfl_xor(v, o);
    return v;
}
__device__ __forceinline__ float wave_max(float v) {
#pragma unroll
    for (int o = 1; o < 64; o <<= 1) v = fmaxf(v, __shfl_xor(v, o));
    return v;
}
__device__ __forceinline__ float sigmoidf_(float x) { return 1.f / (1.f + __expf(-x)); }
__device__ __forceinline__ float gelu_tanh(float y) { const float t = 0.7978845608028654f * (y + 0.044715f * y * y * y); return 0.5f * y * (1.f + tanhf(t)); }

#define XB_TMO      128
#define XB_XCNT(j)  (256  + 64 * (j))
#define XB_XSUB(j)  (1280 + 64 * (j))
#define XB_XGEN(j)  (2304 + 64 * (j))
#define XB_TOP      3328
#define XB_TOPGEN   3392
#define XCD_BAR_WORDS 3456
#define XB_SPIN_CAP (1u << 18)
__device__ __forceinline__ unsigned xb_ld(unsigned* p)              { return __hip_atomic_load(p, __ATOMIC_RELAXED, __HIP_MEMORY_SCOPE_AGENT); }
__device__ __forceinline__ unsigned xb_add(unsigned* p, unsigned v) { return __hip_atomic_fetch_add(p, v, __ATOMIC_RELAXED, __HIP_MEMORY_SCOPE_AGENT); }
__device__ __forceinline__ unsigned xb_xcc_id() { return (unsigned)__builtin_amdgcn_s_getreg((3 << 11) | 20) & 0xFu; }
#define XB_SPIN(cond, bar) do { unsigned _sp = 0; while (cond) { __builtin_amdgcn_s_sleep(1); \
    if ((++_sp & 255u) == 0u) { if (xb_ld(&(bar)[XB_TMO])) break; if (_sp > XB_SPIN_CAP) { atomicAdd(&(bar)[XB_TMO], 1u); break; } } } } while (0)
struct XcdBarrier { unsigned* bar; unsigned x; volatile LAS unsigned* st; };
__device__ __forceinline__ XcdBarrier xcd_barrier_post(unsigned* bar, volatile LAS unsigned* st) {
    XcdBarrier b; b.bar = bar; b.x = xb_xcc_id(); b.st = st;
    if (threadIdx.x == 0) (void)xb_add(&bar[XB_XCNT(b.x)], 1u);
    return b;
}
__device__ __forceinline__ void xcd_barrier_complete(unsigned* bar, unsigned x, unsigned& nloc, unsigned& nx) {
    const unsigned G = gridDim.x * gridDim.y * gridDim.z;
    unsigned sum, cnt, mine, sp = 0u;
    for (;;) {
        sum = 0u; cnt = 0u; mine = 0u;
#pragma unroll
        for (unsigned j = 0; j < 16; ++j) { const unsigned c = xb_ld(&bar[XB_XCNT(j)]); sum += c; cnt += (c > 0u) ? 1u : 0u; mine = (j == x) ? c : mine; }
        if (sum == G) break;
        __builtin_amdgcn_s_sleep(1);
        if ((++sp & 255u) == 0u) { if (xb_ld(&bar[XB_TMO])) break; if (sp > XB_SPIN_CAP) { atomicAdd(&bar[XB_TMO], 1u); break; } }
    }
    nloc = mine > 0u ? mine : 1u; nx = cnt > 0u ? cnt : 1u;
}
__device__ __forceinline__ void xcd_barrier(const XcdBarrier& b) {
    asm volatile("s_waitcnt vmcnt(0)" ::: "memory");
    __syncthreads();
    if (threadIdx.x == 0) {
        unsigned* bar = b.bar;
        __builtin_amdgcn_s_waitcnt(0);
        unsigned nloc = b.st[0], nx = b.st[1];
        if (nloc == 0u) { xcd_barrier_complete(bar, b.x, nloc, nx); b.st[0] = nloc; b.st[1] = nx; }
        const unsigned old = xb_add(&bar[XB_XSUB(b.x)], 1u);
        const unsigned gen = old / nloc;
        if (old + 1u == (gen + 1u) * nloc) {
            __builtin_amdgcn_fence(__ATOMIC_RELEASE, "agent");
            asm volatile("s_waitcnt vmcnt(0)" ::: "memory");
            const unsigned og = xb_add(&bar[XB_TOP], 1u);
            const unsigned tg = og / nx;
            if (og + 1u == (tg + 1u) * nx) xb_add(&bar[XB_TOPGEN], 1u);
            else XB_SPIN(xb_ld(&bar[XB_TOPGEN]) == tg, bar);
            __builtin_amdgcn_fence(__ATOMIC_ACQUIRE, "agent");
            xb_add(&bar[XB_XGEN(b.x)], 1u);
            asm volatile("s_waitcnt vmcnt(0)" ::: "memory");
        } else {
            XB_SPIN(xb_ld(&bar[XB_XGEN(b.x)]) == gen, bar);
            __builtin_amdgcn_fence(__ATOMIC_ACQUIRE, "agent");
            asm volatile("s_waitcnt vmcnt(0)" ::: "memory");
        }
    }
    __syncthreads();
}

struct Args {
    const float* in[25]; float* out; unsigned char* ws; int ph_lo, ph_hi;
};
struct Frame {
    LAS unsigned char* lds;
    int tid, lane, wave, G, bid;
    const float *x, *meta, *w_in, *conv_w, *conv_b, *wa, *ba, *wx, *bx, *lam, *sinks, *g_attn, *g_lru, *w_out, *ln1g, *ln1b,
                *w_group, *b_group, *w_router, *b_router, *w_gate, *w_up, *w_down, *ln2g, *ln2b;
    float* out;
    unsigned char* ws;
    unsigned* ctl;
};

namespace pg8 {
#define PG8_LAS __attribute__((address_space(3)))
typedef unsigned short bf16_t;
typedef short bf16x8 __attribute__((ext_vector_type(8)));
typedef float f32x4 __attribute__((ext_vector_type(4)));
typedef unsigned u32x4 __attribute__((ext_vector_type(4)));
constexpr int BM = 256, BK = 64, HALF = 128, HTB = HALF * BK * 2  , STAGE_BYTES = 8 * HTB, NXCD = 8, WGM = 8;

__host__ __device__ __forceinline__ int lds_byte(int r, int c) { const int st = (r >> 4) * 2 + (c >> 5), rr = r & 15, cc = c & 31, ob = rr * 64 + cc * 2; return st * 1024 + (ob ^ (((ob >> 9) & 1) << 5)); }
__host__ __device__ __forceinline__ void stage_rc(int b, int& R, int& C) { const int st = b / 1024, sb = b % 1024, swz = sb ^ (((sb >> 9) & 1) << 5); R = (st >> 1) * 16 + swz / 64; C = (st & 1) * 32 + (swz % 64) / 2; }
__host__ __device__ __forceinline__ int perm32(int rho) { const int n = rho >> 4, i = rho & 15; return 8 * (i >> 2) + 4 * n + (i & 3); }

struct Unit { int pm, pn, e, aux; };
struct Gemm { const bf16_t* A; const bf16_t* Bt; int M, N, K; };

struct StaticOrder {
    int nM, nN, nwg, G, c;
    __host__ __device__ void init(int M, int N, int G_, int c_) { nM = M / BM; nN = N / BM; nwg = nM * nN; G = G_; c = c_; }
    __host__ __device__ bool next(int i, Unit& u) const {
        const long L = (long)i * G + c; if (L >= nwg) return false;
        int wgid = (int)L; { const int q = nwg / NXCD, r = nwg % NXCD, xcd = wgid % NXCD, off = wgid / NXCD; wgid = (xcd < r ? xcd * (q + 1) : r * (q + 1) + (xcd - r) * q) + off; }
        const int nig = WGM * nN, gid = wgid / nig, fm = gid * WGM, gsz = (nM - fm) < WGM ? (nM - fm) : WGM;
        u.pm = fm + ((wgid % nig) % gsz); u.pn = (wgid % nig) / gsz; u.e = 0; u.aux = 0; return true;
    }
    __device__ __forceinline__ void a_ready(const Unit&) const {}
    __device__ __forceinline__ void done(const Unit&) const {}
    __device__ __forceinline__ size_t a_off(const Unit& u, size_t tstep) const { return (size_t)u.pm * tstep; }
    __device__ __forceinline__ size_t b_off(const Unit& u, size_t tstep) const { return (size_t)u.pn * tstep; }
};

__device__ __forceinline__ unsigned cvt_pk_bf16(float lo, float hi) { unsigned r; asm volatile("v_cvt_pk_bf16_f32 %0, %1, %2" : "=v"(r) : "v"(lo), "v"(hi)); return r; }

__device__ __forceinline__ float gelu_tanh_fast(float y) { const float t = -1.5957691216057308f * (y + 0.044715f * y * y * y); return y * __builtin_amdgcn_rcpf(1.f + __expf(t)); }
struct EpiInProj {
    static constexpr bool PERM = true, AFTER_DRAIN = false;
    bf16_t *Q, *Kb, *Vb, *XR, *GY;
    __device__ __forceinline__ void operator()(const f32x4 (&acc)[2][2][4][2], const Unit& u, int wr, int wc, int fr, int fq) const {
        bf16_t* b0; bf16_t* b1; int ld; bool act = false;
        if (u.pn < 2) { b0 = Q + u.pn * 256; b1 = b0 + 128; ld = 512; }
        else if (u.pn == 2) { b0 = Kb; b1 = Vb; ld = 128; }
        else if (u.pn < 5) { b0 = XR + (u.pn - 3) * 256; b1 = b0 + 128; ld = 512; }
        else { b0 = GY + (u.pn - 5) * 256; b1 = b0 + 128; ld = 512; act = true; }
        const int row0 = u.pm * BM + wr * 64 + fr, col0 = wc * 32 + 8 * fq;
#pragma unroll
        for (int ai = 0; ai < 2; ++ai)
#pragma unroll
            for (int m = 0; m < 4; ++m) { const size_t ro = (size_t)(row0 + ai * HALF + m * 16) * ld + col0;
#pragma unroll
                for (int bj = 0; bj < 2; ++bj) { f32x4 v0 = acc[ai][bj][m][0], v1 = acc[ai][bj][m][1];
                    if (act) {
#pragma unroll
                        for (int j = 0; j < 4; ++j) { v0[j] = gelu_tanh_fast(v0[j]); v1[j] = gelu_tanh_fast(v1[j]); } }
                    u32x4 w; w.x = cvt_pk_bf16(v0[0], v0[1]); w.y = cvt_pk_bf16(v0[2], v0[3]); w.z = cvt_pk_bf16(v1[0], v1[1]); w.w = cvt_pk_bf16(v1[2], v1[3]);
                    *(u32x4*)((bj ? b1 : b0) + ro) = w; } }
    }
};
struct EpiZ {
    static constexpr bool PERM = false, AFTER_DRAIN = false;
    const float* x; float* Z; float alpha;
    __device__ __forceinline__ void operator()(const f32x4 (&acc)[2][2][4][2], const Unit& u, int wr, int wc, int fr, int fq) const {
        const int row0 = u.pm * BM + wr * 64 + fr, col0 = u.pn * BM + wc * 32 + 4 * fq;
#pragma unroll
        for (int ai = 0; ai < 2; ++ai)
#pragma unroll
            for (int m = 0; m < 4; ++m) { const size_t ro = (size_t)(row0 + ai * HALF + m * 16) * 1024 + col0;
#pragma unroll
                for (int bj = 0; bj < 2; ++bj)
#pragma unroll
                    for (int n = 0; n < 2; ++n) { const size_t o = ro + bj * HALF + n * 16; const f32x4 xv = *(const f32x4*)(x + o); *(f32x4*)(Z + o) = xv * alpha + acc[ai][bj][m][n]; } }
    }
};
struct InProjOrder {
    StaticOrder so;
    __device__ void init(int G_, int c_) { so.init(16384, 1792, G_, c_); }
    __device__ bool next(int i, Unit& u) const {
        const long L = (long)i * so.G + so.c;
        if (L < so.nwg) return so.next(i, u);
        if (L < so.nwg + 3) { u.pm = 64; u.pn = 2 + (int)(L - so.nwg); u.e = 0; u.aux = 0; return true; }
        return false;
    }
    __device__ __forceinline__ void a_ready(const Unit&) const {}
    __device__ __forceinline__ void done(const Unit&) const {}
    __device__ __forceinline__ size_t a_off(const Unit& u, size_t tstep) const { return (size_t)u.pm * tstep; }
    __device__ __forceinline__ size_t b_off(const Unit& u, size_t tstep) const { return (size_t)u.pn * tstep; }
};

struct MoeOrder {
    const unsigned* cnt; const int* list; int G, c, nct; size_t ebytes; bool gather;
    __device__ bool next(int i, Unit& u) const {
        const int L = i * G + c, T = L / nct; int acc = 0, pad = 0, e = -1, rt = 0, p = 0;
        for (int j = 0; j < 32; ++j) { const int n = (int)cnt[j], nt = (n + 255) >> 8; if (e < 0 && T < acc + nt) { e = j; rt = T - acc; p = pad; } acc += nt; pad += nt; }
        if (e < 0) return false;
        u.pm = p + rt; u.pn = L % nct; u.e = e; u.aux = rt; return true;
    }
    __device__ __forceinline__ void a_ready(const Unit&) const {}
    __device__ __forceinline__ void done(const Unit&) const {}
    __device__ __forceinline__ size_t a_off(const Unit& u, size_t tstep) const { return gather ? (size_t)0 : (size_t)u.pm * tstep; }
    __device__ __forceinline__ size_t b_off(const Unit& u, size_t tstep) const { return (size_t)u.e * ebytes + (size_t)u.pn * tstep; }
    __device__ __forceinline__ int a_row(const Unit& u, int r) const {
        const int n = (int)cnt[u.e], idx = u.aux * 256 + r; const int* l = list + (size_t)u.e * 16384;
        return l[idx < n ? idx : u.aux * 256] >> 1;
    }
};
struct EpiHid {
    static constexpr bool PERM = true, AFTER_DRAIN = false;
    bf16_t* HID;
    __device__ __forceinline__ void operator()(const f32x4 (&acc)[2][2][4][2], const Unit& u, int wr, int wc, int fr, int fq) const {
        const int row0 = u.pm * BM + wr * 64 + fr, col0 = u.pn * 128 + wc * 32 + 8 * fq;
#pragma unroll
        for (int ai = 0; ai < 2; ++ai)
#pragma unroll
            for (int m = 0; m < 4; ++m) { float h[8];
#pragma unroll
                for (int n = 0; n < 2; ++n)
#pragma unroll
                    for (int j = 0; j < 4; ++j) { const float g = acc[ai][0][m][n][j], up = acc[ai][1][m][n][j]; h[n * 4 + j] = g * __builtin_amdgcn_rcpf(1.f + __expf(-g)) * up; }
                u32x4 w; w.x = cvt_pk_bf16(h[0], h[1]); w.y = cvt_pk_bf16(h[2], h[3]); w.z = cvt_pk_bf16(h[4], h[5]); w.w = cvt_pk_bf16(h[6], h[7]);
                *(u32x4*)(HID + (size_t)(row0 + ai * HALF + m * 16) * 512 + col0) = w; }
    }
};
struct EpiYB {
    static constexpr bool PERM = true, AFTER_DRAIN = false;
    bf16_t* YB; const int* list; const float* gate; const unsigned* cnt;
    __device__ __forceinline__ void operator()(const f32x4 (&acc)[2][2][4][2], const Unit& u, int wr, int wc, int fr, int fq) const {
        const int n = (int)cnt[u.e]; const int* l = list + (size_t)u.e * 16384 + u.aux * 256; const int nrow = n - u.aux * 256;
        const int col0 = u.pn * BM + wc * 32 + 8 * fq;
#pragma unroll
        for (int ai = 0; ai < 2; ++ai)
#pragma unroll
            for (int m = 0; m < 4; ++m) { const int r = ai * HALF + wr * 64 + m * 16 + fr;
                if (r < nrow) { const int slot = l[r]; const float gt = gate[slot];
#pragma unroll
                    for (int bj = 0; bj < 2; ++bj) { const f32x4 v0 = acc[ai][bj][m][0] * gt, v1 = acc[ai][bj][m][1] * gt;
                        u32x4 w; w.x = cvt_pk_bf16(v0[0], v0[1]); w.y = cvt_pk_bf16(v0[2], v0[3]); w.z = cvt_pk_bf16(v1[0], v1[1]); w.w = cvt_pk_bf16(v1[2], v1[3]);
                        *(u32x4*)(YB + (size_t)slot * 1024 + col0 + bj * HALF) = w; } } }
    }
};

template <class Epi, class Sched, bool ALIGN_EPI = false, bool SP2 = false, bool GATHER = false>
__device__ __forceinline__ void gemm_phase(PG8_LAS unsigned char* lds, const Gemm g, const Sched& S, const Epi& E) {
    const int tid = threadIdx.x, wid = __builtin_amdgcn_readfirstlane(tid >> 6), lane = tid & 63, wr = wid >> 2, wc = wid & 3, fr = lane & 15, fq = lane >> 4;
    const int K = g.K, nt = K / BK;
    unsigned voffA[2], voffB[2];
#pragma unroll
    for (int i = 0; i < 2; ++i) { int R, C; stage_rc(tid * 16 + i * 8192, R, C); const int Rb = Epi::PERM ? ((R & ~31) + perm32(R & 31)) : R;
        voffA[i] = (unsigned)(R * K + C) * 2u; voffB[i] = (unsigned)(Rb * K + C) * 2u; }
    const size_t kstep = (size_t)(BK * 2);
    const size_t hstep = (size_t)HALF * K * 2;
    const size_t tstep = 2 * hstep;
    const unsigned ldsw = (unsigned)wid * 1024u;
    const int aoff = lds_byte(wr * 64 + fr, fq * 8), boff = lds_byte(wc * 32 + fr, fq * 8);
#define PG8_SA(b, h) (((b) * 2 + (h)) * HTB)
#define PG8_SB(b, h) ((4 + (b) * 2 + (h)) * HTB)
#define PG8_STAGE(bufoff, gbase, voff) do { _Pragma("unroll") for (int _i = 0; _i < 2; ++_i) \
        __builtin_amdgcn_global_load_lds((const unsigned*)((const char*)(gbase) + (voff)[_i]), (PG8_LAS unsigned*)(lds + (bufoff) + ldsw + _i * 8192), 16, 0, 0); } while (0)
#define PG8_STAGE_A(bufoff, gbase, h, nx) do { if constexpr (GATHER) { unsigned _vo[2]; const bool _n = (nx) && has_next_g; _vo[0] = _n ? nVA[h][0] : cVA[h][0]; _vo[1] = _n ? nVA[h][1] : cVA[h][1]; PG8_STAGE(bufoff, gbase, _vo); } \
        else { PG8_STAGE(bufoff, (gbase) + (size_t)(h) * hstep, voffA); } } while (0)
#define PG8_LDA(dst, b, h) do { _Pragma("unroll") for (int m = 0; m < 4; ++m) _Pragma("unroll") for (int k = 0; k < 2; ++k) dst[m][k] = *(const PG8_LAS bf16x8*)(lds + PG8_SA(b, h) + aoff + m * 2048 + k * 1024); } while (0)
#define PG8_LDB(dst, b, h) do { _Pragma("unroll") for (int n = 0; n < 2; ++n) _Pragma("unroll") for (int k = 0; k < 2; ++k) dst[n][k] = *(const PG8_LAS bf16x8*)(lds + PG8_SB(b, h) + boff + n * 2048 + k * 1024); } while (0)
#define PG8_MMA(ai, bj, At, Bt) do { __builtin_amdgcn_s_setprio(1); _Pragma("unroll") for (int m = 0; m < 4; ++m) _Pragma("unroll") for (int n = 0; n < 2; ++n) _Pragma("unroll") for (int k = 0; k < 2; ++k) \
        acc[ai][bj][m][n] = __builtin_amdgcn_mfma_f32_16x16x32_bf16(Bt[n][k], At[m][k], acc[ai][bj][m][n], 0, 0, 0); __builtin_amdgcn_s_setprio(0); } while (0)
#define PG8_WAIT_V(n) asm volatile("s_waitcnt vmcnt(" #n ")" ::: "memory")
#define PG8_WAIT_L(n) asm volatile("s_waitcnt lgkmcnt(" #n ")" ::: "memory")
#define PG8_BAR __builtin_amdgcn_s_barrier()
#define PG8_SCHED __builtin_amdgcn_sched_barrier(0)
    Unit cur, nxt; int ui = 0;
    if (!S.next(0, cur)) return;
    unsigned cVA[2][2] = {{0u, 0u}, {0u, 0u}}, nVA[2][2] = {{0u, 0u}, {0u, 0u}}; bool has_next_g = false; int gR[2], gC[2];
    if constexpr (GATHER) {
#pragma unroll
        for (int i = 0; i < 2; ++i) stage_rc(tid * 16 + i * 8192, gR[i], gC[i]);
#pragma unroll
        for (int h = 0; h < 2; ++h)
#pragma unroll
            for (int i = 0; i < 2; ++i) cVA[h][i] = (unsigned)(S.a_row(cur, h * HALF + gR[i]) * K + gC[i]) * 2u;
    }
    f32x4 acc[2][2][4][2];
#pragma unroll
    for (int a = 0; a < 2; ++a)
#pragma unroll
        for (int b = 0; b < 2; ++b)
#pragma unroll
            for (int m = 0; m < 4; ++m)
#pragma unroll
                for (int n = 0; n < 2; ++n) acc[a][b][m][n] = (f32x4){0.f, 0.f, 0.f, 0.f};
    bf16x8 At[4][2], B0[2][2], B1[2][2];
    const char* cA = (const char*)g.A + S.a_off(cur, tstep); const char* cB = (const char*)g.Bt + S.b_off(cur, tstep);
    S.a_ready(cur);
    if constexpr (SP2) {
        PG8_STAGE(PG8_SB(0, 0), cB, voffB); PG8_STAGE(PG8_SB(0, 1), cB + hstep, voffB); PG8_STAGE_A(PG8_SA(0, 0), cA, 0, false); PG8_STAGE_A(PG8_SA(0, 1), cA, 1, false);
        if (wr == 1) PG8_BAR;
        PG8_WAIT_V(2); PG8_BAR;
        PG8_STAGE(PG8_SB(1, 0), cB + kstep, voffB); PG8_STAGE_A(PG8_SA(1, 0), cA + kstep, 0, false); PG8_STAGE(PG8_SB(1, 1), cB + hstep + kstep, voffB);
        PG8_WAIT_V(6); PG8_BAR;
    } else {
        PG8_STAGE(PG8_SB(0, 0), cB, voffB); PG8_STAGE_A(PG8_SA(0, 0), cA, 0, false); PG8_STAGE(PG8_SB(0, 1), cB + hstep, voffB); PG8_STAGE_A(PG8_SA(0, 1), cA, 1, false);
        if (wr == 1) PG8_BAR;
        PG8_WAIT_V(4); PG8_BAR;
        PG8_STAGE(PG8_SB(1, 0), cB + kstep, voffB); PG8_STAGE_A(PG8_SA(1, 0), cA + kstep, 0, false); PG8_STAGE(PG8_SB(1, 1), cB + hstep + kstep, voffB);
        PG8_WAIT_V(6); PG8_BAR;
    }
    for (;;) {
        const bool has_next = S.next(ui + 1, nxt);
        if constexpr (GATHER) { has_next_g = has_next; if (has_next) {
#pragma unroll
            for (int h = 0; h < 2; ++h)
#pragma unroll
                for (int i = 0; i < 2; ++i) nVA[h][i] = (unsigned)(S.a_row(nxt, h * HALF + gR[i]) * K + gC[i]) * 2u; } }
        const char* nA = has_next ? (const char*)g.A + S.a_off(nxt, tstep) : cA; const char* nB = has_next ? (const char*)g.Bt + S.b_off(nxt, tstep) : cB;
        for (int t = 0; t < nt; t += 2) {
            const bool last = (t == nt - 2);
            const char* a1 = cA + (size_t)(t + 1) * kstep;
            const char* a2 = last ? nA : cA + (size_t)(t + 2) * kstep; const char* b2 = last ? nB : cB + (size_t)(t + 2) * kstep;
            const char* a3 = a2 + kstep; const char* b3 = b2 + kstep;
            if (last && has_next) S.a_ready(nxt);
            if constexpr (SP2) {
            PG8_LDB(B0, 0, 0); PG8_LDB(B1, 0, 1); PG8_SCHED; PG8_LDA(At, 0, 0); PG8_STAGE_A(PG8_SA(1, 1), a1, 1, false);
            PG8_WAIT_V(8); PG8_WAIT_L(0); PG8_BAR; PG8_MMA(0, 0, At, B0); PG8_MMA(0, 1, At, B1); PG8_BAR; PG8_SCHED;
            PG8_LDA(At, 0, 1); PG8_STAGE(PG8_SB(0, 0), b2, voffB); PG8_STAGE(PG8_SB(0, 1), b2 + hstep, voffB); PG8_STAGE_A(PG8_SA(0, 0), a2, 0, last);
            PG8_WAIT_V(8); PG8_WAIT_L(0); PG8_BAR; PG8_MMA(1, 0, At, B0); PG8_MMA(1, 1, At, B1); PG8_BAR; PG8_SCHED;
            PG8_LDB(B0, 1, 0); PG8_LDB(B1, 1, 1); PG8_SCHED; PG8_LDA(At, 1, 0); PG8_STAGE_A(PG8_SA(0, 1), a2, 1, last);
            PG8_WAIT_V(8); PG8_WAIT_L(0); PG8_BAR; PG8_MMA(0, 0, At, B0); PG8_MMA(0, 1, At, B1); PG8_BAR; PG8_SCHED;
            PG8_LDA(At, 1, 1); PG8_STAGE(PG8_SB(1, 0), b3, voffB); PG8_STAGE(PG8_SB(1, 1), b3 + hstep, voffB); PG8_STAGE_A(PG8_SA(1, 0), a3, 0, last);
            PG8_WAIT_V(8); PG8_WAIT_L(0); PG8_BAR; PG8_MMA(1, 0, At, B0); PG8_MMA(1, 1, At, B1); PG8_BAR; PG8_SCHED;
            } else {
            PG8_LDB(B0, 0, 0); PG8_SCHED; PG8_LDA(At, 0, 0); PG8_STAGE_A(PG8_SA(1, 1), a1, 1, false);
            PG8_WAIT_L(8); PG8_BAR; PG8_WAIT_L(0); PG8_MMA(0, 0, At, B0); PG8_BAR; PG8_SCHED;
            PG8_LDB(B1, 0, 1); PG8_STAGE(PG8_SB(0, 0), b2, voffB);
            PG8_BAR; PG8_WAIT_L(0); PG8_MMA(0, 1, At, B1); PG8_BAR;
            PG8_LDA(At, 0, 1); PG8_STAGE_A(PG8_SA(0, 0), a2, 0, last);
            PG8_BAR; PG8_WAIT_L(0); PG8_MMA(1, 0, At, B0); PG8_BAR; PG8_SCHED;
            PG8_STAGE(PG8_SB(0, 1), b2 + hstep, voffB);
            PG8_WAIT_V(6); PG8_BAR; PG8_MMA(1, 1, At, B1); PG8_BAR;
            PG8_LDB(B0, 1, 0); PG8_SCHED; PG8_LDA(At, 1, 0); PG8_STAGE_A(PG8_SA(0, 1), a2, 1, last);
            PG8_WAIT_L(8); PG8_BAR; PG8_WAIT_L(0); PG8_MMA(0, 0, At, B0); PG8_BAR; PG8_SCHED;
            PG8_LDB(B1, 1, 1); PG8_STAGE(PG8_SB(1, 0), b3, voffB);
            PG8_BAR; PG8_WAIT_L(0); PG8_MMA(0, 1, At, B1); PG8_BAR;
            PG8_LDA(At, 1, 1); PG8_STAGE_A(PG8_SA(1, 0), a3, 0, last);
            PG8_BAR; PG8_WAIT_L(0); PG8_MMA(1, 0, At, B0); PG8_BAR; PG8_SCHED;
            PG8_STAGE(PG8_SB(1, 1), b3 + hstep, voffB);
            PG8_WAIT_V(6); PG8_BAR; PG8_MMA(1, 1, At, B1); PG8_BAR;
            }
        }
        if constexpr (ALIGN_EPI) { if (wr == 0) PG8_BAR; }
        if constexpr (!Epi::AFTER_DRAIN) { E(acc, cur, wr, wc, fr, fq); S.done(cur); }
        if (!has_next) break;
#pragma unroll
        for (int a = 0; a < 2; ++a)
#pragma unroll
            for (int b = 0; b < 2; ++b)
#pragma unroll
                for (int m = 0; m < 4; ++m)
#pragma unroll
                    for (int n = 0; n < 2; ++n) acc[a][b][m][n] = (f32x4){0.f, 0.f, 0.f, 0.f};
        cur = nxt; cA = nA; cB = nB; ++ui;
        if constexpr (GATHER) {
#pragma unroll
            for (int h = 0; h < 2; ++h)
#pragma unroll
                for (int i = 0; i < 2; ++i) cVA[h][i] = nVA[h][i]; }
        if constexpr (ALIGN_EPI) { if (wr == 1) PG8_BAR; }
    }
    PG8_WAIT_V(0);
    if constexpr (!ALIGN_EPI) { if (wr == 0) PG8_BAR; }
    PG8_BAR;
    if constexpr (Epi::AFTER_DRAIN) { E.fused(acc, cur, wr, wc, fr, fq, lds, wid, lane); S.done(cur); }
#undef PG8_SA
#undef PG8_SB
#undef PG8_STAGE
#undef PG8_STAGE_A
#undef PG8_LDA
#undef PG8_LDB
#undef PG8_MMA
#undef PG8_WAIT_V
#undef PG8_WAIT_L
#undef PG8_BAR
#undef PG8_SCHED
}
}


#define LDS_WAIT() asm volatile("s_waitcnt lgkmcnt(0)" ::: "memory")
__device__ __forceinline__ unsigned pk2(float lo, float hi) { return f2bf(lo) | (f2bf(hi) << 16); }
__device__ __forceinline__ void p0_transpose_item(const float* W, int K, int N, bf16* WT, int row_off, LAS float* scr, int item, int lane) {
    const int nblk = N / 32, kb = item / nblk, nb = item % nblk, k0 = 64 * kb, n0 = 32 * nb;
#pragma unroll 8
    for (int i = 0; i < 32; ++i) { const int kk = 2 * i + (lane >> 5); scr[kk * 33 + (lane & 31)] = W[(size_t)(k0 + kk) * N + n0 + (lane & 31)]; }
    LDS_WAIT(); asm volatile("" ::: "memory");
    const int c = lane & 7;
#pragma unroll
    for (int j = 0; j < 4; ++j) { const int n = (lane >> 3) + 8 * j; const LAS float* s = scr + (8 * c) * 33 + n;
        v4u o; o.x = pk2(s[0 * 33], s[1 * 33]); o.y = pk2(s[2 * 33], s[3 * 33]); o.z = pk2(s[4 * 33], s[5 * 33]); o.w = pk2(s[6 * 33], s[7 * 33]);
        *(GAS v4u*)(WT + (size_t)(row_off + n0 + n) * K + k0 + 8 * c) = o; }
    LDS_WAIT(); asm volatile("" ::: "memory");
}

__device__ __forceinline__ void row_to_bf16(const float* src, bf16* dst, int lane) {
#pragma unroll
    for (int j = 0; j < 2; ++j) { const f32x4 a = *(const f32x4*)(src + 512 * j + 8 * lane), b = *(const f32x4*)(src + 512 * j + 8 * lane + 4);
        v4u o; o.x = pk2(a[0], a[1]); o.y = pk2(a[2], a[3]); o.z = pk2(b[0], b[1]); o.w = pk2(b[2], b[3]); *(v4u*)(dst + 512 * j + 8 * lane) = o; }
}
__device__ __forceinline__ void ph_convert(Frame& F) {
    LAS float* scr = (LAS float*)(F.lds + F.wave * 16384);
    const int gw = F.bid * NWAVES + F.wave, NGW = F.G * NWAVES;
    bf16* WINT = (bf16*)(F.ws + WS_WINT); bf16* WOUTT = (bf16*)(F.ws + WS_WOUTT); bf16* XB = (bf16*)(F.ws + WS_XB);
    constexpr int I_IN = (DM / 64) * (INC / 32), I_OUT = (DM / 64) * (DM / 32);
    for (int it = gw; it < I_IN + I_OUT; it += NGW) {
        if (it < I_IN) p0_transpose_item(F.w_in, DM, INC, WINT, 0, scr, it, F.lane);
        else p0_transpose_item(F.w_out, DM, DM, WOUTT, 0, scr, it - I_IN, F.lane);
    }
    { bf16* WT = (bf16*)(F.ws + WS_GWT);
      for (int i = F.bid * NTHR + F.tid; i < 65536; i += F.G * NTHR) { const int G_ = i >> 15, n = (i >> 12) & 7, d = (i >> 6) & 63, c = i & 63;
          WT[i] = (bf16)f2bf((G_ ? F.wx : F.wa)[(n * 64 + c) * 64 + d]); } }
    for (int r = gw; r < 16640; r += NGW) {
        bf16* dst = XB + (size_t)r * DM;
        if (r < NTOK) row_to_bf16(F.x + (size_t)r * DM, dst, F.lane);
        else if (r < NROW) row_to_bf16(F.meta + (size_t)(r - NTOK) * DM, dst, F.lane);
        else { const v4u z = {0u, 0u, 0u, 0u}; *(v4u*)(dst + 8 * F.lane) = z; *(v4u*)(dst + 512 + 8 * F.lane) = z; }
    }
}

__device__ __forceinline__ void ph_convert_moe(Frame& F) {
    LAS float* scr = (LAS float*)(F.lds + F.wave * 16384);
    const int gw = F.bid * NWAVES + F.wave, NGW = F.G * NWAVES;
    bf16* WGUT = (bf16*)(F.ws + WS_WGUT); bf16* WDT = (bf16*)(F.ws + WS_WDT);
    constexpr int I_G = (DM / 64) * (DFF / 32), I_D = (DFF / 64) * (DM / 32), I_E = 2 * I_G + I_D;
    for (int it = gw; it < NEXP * I_E; it += NGW) {
        const int e = it / I_E; int r = it % I_E;
        if (r < 2 * I_G) { const int up = r >= I_G; if (up) r -= I_G; const int nb = r % (DFF / 32), n0 = nb * 32;
            const int row_off = (n0 >> 7) * 256 + (n0 & 127) + (up ? 128 : 0) - n0;
            p0_transpose_item((up ? F.w_up : F.w_gate) + (size_t)e * DM * DFF, DM, DFF, WGUT + (size_t)e * 1024 * DM, row_off, scr, r, F.lane); }
        else p0_transpose_item(F.w_down + (size_t)e * DFF * DM, DFF, DM, WDT + (size_t)e * DM * DFF, 0, scr, r - 2 * I_G, F.lane);
    }
}

typedef short bf16x8_t __attribute__((ext_vector_type(8)));
constexpr int LRU_WAVE_LDS = 17408;
__device__ __forceinline__ void lru_local_wave(Frame& F, LAS unsigned char* wl, int rowbase, int hist, int n_mt, bool store, int n, float* aggA, float* aggB) {
    const int lane = F.lane, ch = n * 64 + lane;
    const bf16* XR = (const bf16*)(F.ws + WS_XR); bf16* HLOC = (bf16*)(F.ws + WS_HLOC); bf16* PCUM = (bf16*)(F.ws + WS_PCUM);
    const bf16* WT = (const bf16*)(F.ws + WS_GWT);
    LAS bf16* xcs = (LAS bf16*)wl; LAS float* AUa = (LAS float*)(wl + 9216); LAS float* AUu = AUa + 1024;
    {
        const float w0 = F.conv_w[ch], w1 = F.conv_w[512 + ch], w2 = F.conv_w[1024 + ch], w3 = F.conv_w[1536 + ch], cb = F.conv_b[ch];
        float x0 = 0.f, x1 = 0.f, x2 = 0.f;
        if (hist >= 0) { x0 = bf2f(XR[(size_t)hist * 512 + ch]); x1 = bf2f(XR[(size_t)(hist + 1) * 512 + ch]); x2 = bf2f(XR[(size_t)(hist + 2) * 512 + ch]); }
        const int nt_ = n_mt * 16;
#pragma unroll 8
        for (int t = 0; t < nt_; ++t) { const float x3 = bf2f(XR[(size_t)(rowbase + t) * 512 + ch]);
            xcs[t * 72 + lane] = (bf16)f2bf(cb + w0 * x0 + w1 * x1 + w2 * x2 + w3 * x3); x0 = x1; x1 = x2; x2 = x3; }
    }
    const int fr = lane & 15, fq = lane >> 4;
    bf16x8_t bw[2][4][2];
#pragma unroll
    for (int G_ = 0; G_ < 2; ++G_)
#pragma unroll
        for (int nt = 0; nt < 4; ++nt)
#pragma unroll
            for (int k = 0; k < 2; ++k) bw[G_][nt][k] = *(const bf16x8_t*)(WT + (size_t)G_ * 32768 + (size_t)(n * 64 + nt * 16 + fr) * 64 + k * 32 + fq * 8);
    float ba_[4], bx_[4], sp_[4];
#pragma unroll
    for (int nt = 0; nt < 4; ++nt) { const int c2 = n * 64 + nt * 16 + fr; ba_[nt] = F.ba[c2]; bx_[nt] = F.bx[c2]; const float nl = -F.lam[c2]; sp_[nt] = fmaxf(nl, 0.f) + log1pf(__expf(-fabsf(nl))); }
    asm volatile("s_waitcnt lgkmcnt(0)" ::: "memory");
    float h = 0.f, p = 1.f;
    for (int mt = 0; mt < n_mt; ++mt) {
        bf16x8_t af[2];
#pragma unroll
        for (int k = 0; k < 2; ++k) af[k] = *(const LAS bf16x8_t*)((const LAS unsigned char*)xcs + (mt * 16 + fr) * 144 + k * 64 + fq * 16);
        f32x4 R[4], I[4];
#pragma unroll
        for (int nt = 0; nt < 4; ++nt) { R[nt] = (f32x4){0.f, 0.f, 0.f, 0.f}; I[nt] = (f32x4){0.f, 0.f, 0.f, 0.f};
#pragma unroll
            for (int k = 0; k < 2; ++k) { R[nt] = __builtin_amdgcn_mfma_f32_16x16x32_bf16(af[k], bw[0][nt][k], R[nt], 0, 0, 0); I[nt] = __builtin_amdgcn_mfma_f32_16x16x32_bf16(af[k], bw[1][nt][k], I[nt], 0, 0, 0); } }
#pragma unroll
        for (int nt = 0; nt < 4; ++nt)
#pragma unroll
            for (int j = 0; j < 4; ++j) { const int tl = fq * 4 + j, d = nt * 16 + fr;
                const float xcv = bf2f(xcs[(mt * 16 + tl) * 72 + d]);
                const float r = __builtin_amdgcn_rcpf(1.f + __expf(-(R[nt][j] + ba_[nt]))), ig = __builtin_amdgcn_rcpf(1.f + __expf(-(I[nt][j] + bx_[nt])));
                const float a = __expf(-8.0f * r * sp_[nt]);
                AUa[tl * 64 + d] = a; AUu[tl * 64 + d] = sqrtf(fmaxf(1.f - a * a, 0.f)) * (ig * xcv); }
        asm volatile("s_waitcnt lgkmcnt(0)" ::: "memory");
#pragma unroll 4
        for (int tl = 0; tl < 16; ++tl) { const float a = AUa[tl * 64 + lane], u = AUu[tl * 64 + lane]; h = a * h + u; p *= a;
            if (store) { const size_t o = (size_t)(rowbase + mt * 16 + tl) * 512 + ch; HLOC[o] = (bf16)f2bf(h); PCUM[o] = (bf16)f2bf(p); } }
        asm volatile("s_waitcnt lgkmcnt(0)" ::: "memory");
    }
    aggA[ch] = p; aggB[ch] = h;
}
__device__ __forceinline__ void ph_lru_local(Frame& F) {
    LAS unsigned char* wl = F.lds + F.wave * LRU_WAVE_LDS;
    float* AGGA = (float*)(F.ws + WS_AGG); float* AGGB = AGGA + 4 * 64 * 512; float* HMETA = AGGB + 4 * 64 * 512;
    for (int it = F.bid; it < 257; it += F.G) {
        if (it < 256) { const int b = it >> 6, c = it & 63, rowbase = b * SEQ + c * 64;
            lru_local_wave(F, wl, rowbase, c == 0 ? NTOK + 13 : rowbase - 3, 4, true, F.wave, AGGA + (size_t)it * 512, AGGB + (size_t)it * 512); }
        else lru_local_wave(F, wl, NTOK, -1, 1, false, F.wave, HMETA + 512, HMETA);
    }
}
__device__ __forceinline__ void ph_merge(Frame& F) {
    const bf16* GY = (const bf16*)(F.ws + WS_GY);
    const bf16* HLOC = (const bf16*)(F.ws + WS_HLOC); const bf16* PCUM = (const bf16*)(F.ws + WS_PCUM);
    const float* AGGA = (const float*)(F.ws + WS_AGG); const float* AGGB = AGGA + 4 * 64 * 512; const float* HMETA = AGGB + 4 * 64 * 512;
    bf16* MRG = (bf16*)(F.ws + WS_MRG);
    LAS float* carry = (LAS float*)F.lds;
    const int lane = F.lane;
    for (int it = F.bid; it < 256; it += F.G) {
        const int b = it >> 6, c = it & 63;
        __syncthreads();
        { float cr = HMETA[F.tid]; const float* pa = AGGA + (size_t)(b * 64) * 512 + F.tid; const float* pb = AGGB + (size_t)(b * 64) * 512 + F.tid;
          for (int j = 0; j < c; ++j) cr = pb[(size_t)j * 512] + pa[(size_t)j * 512] * cr;
          carry[F.tid] = cr; }
        __syncthreads();
        for (int t = F.wave; t < 64; t += NWAVES) {
            const int row = it * 64 + t;
            const v4u hv = *(const v4u*)(HLOC + (size_t)row * 512 + 8 * lane), pv = *(const v4u*)(PCUM + (size_t)row * 512 + 8 * lane), gv = *(const v4u*)(GY + (size_t)row * 512 + 8 * lane);
            float l[8]; float sl = 0.f;
#pragma unroll
            for (int j = 0; j < 4; ++j) {
                const float c0 = carry[8 * lane + 2 * j], c1 = carry[8 * lane + 2 * j + 1];
                const float h0 = __builtin_bit_cast(float, hv[j] << 16) + __builtin_bit_cast(float, pv[j] << 16) * c0, h1 = __builtin_bit_cast(float, hv[j] & 0xffff0000u) + __builtin_bit_cast(float, pv[j] & 0xffff0000u) * c1;
                l[2 * j] = h0 * __builtin_bit_cast(float, gv[j] << 16); l[2 * j + 1] = h1 * __builtin_bit_cast(float, gv[j] & 0xffff0000u);
                sl += l[2 * j] * l[2 * j] + l[2 * j + 1] * l[2 * j + 1]; }
            const float rl = 1.f / sqrtf(wave_sum(sl) * (1.f / 512.f) + EPS);
            { const f32x4 g0 = *(const f32x4*)(F.g_lru + 8 * lane), g1 = *(const f32x4*)(F.g_lru + 8 * lane + 4);
              v4u o; o.x = pk2(l[0] * rl * g0[0], l[1] * rl * g0[1]); o.y = pk2(l[2] * rl * g0[2], l[3] * rl * g0[3]); o.z = pk2(l[4] * rl * g1[0], l[5] * rl * g1[1]); o.w = pk2(l[6] * rl * g1[2], l[7] * rl * g1[3]);
              *(v4u*)(MRG + (size_t)row * 1024 + 512 + 8 * lane) = o; }
        }
    }
}

typedef float f32x16 __attribute__((ext_vector_type(16)));
typedef short s16x4_t __attribute__((ext_vector_type(4)));
constexpr int AT_KROW = 272, AT_VROW = 392, AT_VT_OFF = 192 * AT_KROW, AT_SSQ_OFF = AT_VT_OFF + 128 * AT_VROW;
__device__ __forceinline__ void ph_attn(Frame& F) {
    const bf16* Q = (const bf16*)(F.ws + WS_Q); const bf16* Kb = (const bf16*)(F.ws + WS_K); const bf16* Vb = (const bf16*)(F.ws + WS_V);
    bf16* MRG = (bf16*)(F.ws + WS_MRG);
    LAS unsigned char* lds = F.lds; LAS float* ssq = (LAS float*)(lds + AT_SSQ_OFF);
    const int lane = F.lane, qi = lane & 31, hh = lane >> 5, hq = F.wave, kvh = hq >> 2;
    const float slope = exp2f(-(float)(hq + 1)), sink = F.sinks[hq];
    for (int it = F.bid; it < 256; it += F.G) {
        const int b = it >> 6, s0 = (it & 63) * 64;
        __syncthreads();
#pragma unroll
        for (int i = 0; i < 6; ++i) {
            const int id = F.tid + i * 512, key = id >> 4, c16 = id & 15, kap = s0 - 128 + key;
            const int row = kap >= 0 ? b * SEQ + kap : (kap >= -16 ? NTOK + 16 + kap : NTOK);
            const v4u kv = *(const v4u*)(Kb + (size_t)row * 128 + c16 * 8), vv = *(const v4u*)(Vb + (size_t)row * 128 + c16 * 8);
            *(LAS v4u*)(lds + key * AT_KROW + c16 * 16) = kv;
            LAS unsigned char* vt = lds + AT_VT_OFF + ((c16 >> 3) * 64 + (c16 & 7) * 8) * AT_VROW + key * 2;
#pragma unroll
            for (int j = 0; j < 8; ++j) *(LAS bf16*)(vt + j * AT_VROW) = (bf16)((vv[j >> 1] >> (16 * (j & 1))) & 0xffffu);
        }
        __syncthreads();
        const int kmin = 112 - s0;
#pragma unroll 1
        for (int sb = 0; sb < 2; ++sb) {
            const int row = b * SEQ + s0 + 32 * sb + qi;
            bf16x8_t qf[4];
#pragma unroll
            for (int ks = 0; ks < 4; ++ks) qf[ks] = *(const bf16x8_t*)(Q + (size_t)row * 512 + hq * 64 + ks * 16 + 8 * hh);
            f32x16 S[5];
#pragma unroll
            for (int tt = 0; tt < 5; ++tt) {
#pragma unroll
                for (int r = 0; r < 16; ++r) S[tt][r] = 0.f;
#pragma unroll
                for (int ks = 0; ks < 4; ++ks) { const bf16x8_t kf = *(const LAS bf16x8_t*)(lds + ((sb + tt) * 32 + qi) * AT_KROW + kvh * 128 + ks * 32 + hh * 16);
                    S[tt] = __builtin_amdgcn_mfma_f32_32x32x16_bf16(kf, qf[ks], S[tt], 0, 0, 0); }
            }
            float m = sink;
#pragma unroll
            for (int tt = 0; tt < 5; ++tt)
#pragma unroll
                for (int r = 0; r < 16; ++r) { const int kidx = (sb + tt) * 32 + (r & 3) + 8 * (r >> 2) + 4 * hh, dist = 128 + 32 * sb + qi - kidx;
                    const bool ok = ((unsigned)dist < 128u) && (kidx >= kmin);
                    const float lg = ok ? S[tt][r] * 0.125f - slope * (float)dist : -1e30f; S[tt][r] = lg; m = fmaxf(m, lg); }
            m = fmaxf(m, __shfl_xor(m, 32));
            float ls = 0.f;
#pragma unroll
            for (int tt = 0; tt < 5; ++tt)
#pragma unroll
                for (int r = 0; r < 16; ++r) { const float pz = S[tt][r] > -1e29f ? __expf(S[tt][r] - m) : 0.f; S[tt][r] = pz; ls += pz; }
            ls += __shfl_xor(ls, 32); ls += __expf(sink - m);
            const float linv = 1.f / ls;
            f32x16 O[2];
#pragma unroll
            for (int mt = 0; mt < 2; ++mt)
#pragma unroll
                for (int r = 0; r < 16; ++r) O[mt][r] = 0.f;
#pragma unroll
            for (int tt = 0; tt < 5; ++tt)
#pragma unroll
                for (int s2 = 0; s2 < 2; ++s2) {
                    bf16x8_t pf;
#pragma unroll
                    for (int j = 0; j < 8; ++j) pf[j] = (short)f2bf(S[tt][8 * s2 + j]);
#pragma unroll
                    for (int mt = 0; mt < 2; ++mt) {
                        const LAS unsigned char* vp = lds + AT_VT_OFF + (kvh * 64 + mt * 32 + qi) * AT_VROW + ((sb + tt) * 32 + 16 * s2 + 4 * hh) * 2;
                        const s16x4_t lo = *(const LAS s16x4_t*)vp, hi = *(const LAS s16x4_t*)(vp + 16);
                        const bf16x8_t vf = __builtin_shufflevector(lo, hi, 0, 1, 2, 3, 4, 5, 6, 7);
                        O[mt] = __builtin_amdgcn_mfma_f32_32x32x16_bf16(vf, pf, O[mt], 0, 0, 0);
                    }
                }
            float q2 = 0.f;
#pragma unroll
            for (int mt = 0; mt < 2; ++mt)
#pragma unroll
                for (int r = 0; r < 16; ++r) { const float o = O[mt][r] * linv; O[mt][r] = o; q2 += o * o; }
            q2 += __shfl_xor(q2, 32);
            if (hh == 0) ssq[(32 * sb + qi) * 8 + hq] = q2;
            __syncthreads();
            const f32x4 s0v = *(const LAS f32x4*)(ssq + (32 * sb + qi) * 8), s1v = *(const LAS f32x4*)(ssq + (32 * sb + qi) * 8 + 4);
            const float tot = (s0v[0] + s0v[1]) + (s0v[2] + s0v[3]) + (s1v[0] + s1v[1]) + (s1v[2] + s1v[3]);
            const float rstd = 1.f / sqrtf(tot * (1.f / 512.f) + EPS);
#pragma unroll
            for (int mt = 0; mt < 2; ++mt)
#pragma unroll
                for (int g = 0; g < 4; ++g) { const int dim = mt * 32 + 8 * g + 4 * hh; const f32x4 gv = *(const f32x4*)(F.g_attn + hq * 64 + dim);
                    const unsigned w0 = pk2(O[mt][4 * g] * rstd * gv[0], O[mt][4 * g + 1] * rstd * gv[1]), w1 = pk2(O[mt][4 * g + 2] * rstd * gv[2], O[mt][4 * g + 3] * rstd * gv[3]);
                    *(unsigned long long*)(MRG + (size_t)row * 1024 + hq * 64 + dim) = (unsigned long long)w0 | ((unsigned long long)w1 << 32); }
        }
    }
}
template <class AF, class BF>
__device__ __forceinline__ void ngemm_tile(LAS float* sm, int K, AF af, BF bf, float (&acc)[4][4], int tid) {
    LAS float* As = sm;
    LAS float* Bs = sm + 16 * 68;
    const int ty = tid >> 5, tx = tid & 31;
#pragma unroll
    for (int i = 0; i < 4; ++i)
#pragma unroll
        for (int j = 0; j < 4; ++j) acc[i][j] = 0.f;
    for (int k0 = 0; k0 < K; k0 += 16) {
        float av[2], bv[4];
#pragma unroll
        for (int i = 0; i < 2; ++i) { const int e = tid + i * 512; av[i] = af(e >> 4, k0 + (e & 15)); }
#pragma unroll
        for (int i = 0; i < 4; ++i) { const int e = tid + i * 512; bv[i] = bf(k0 + (e >> 7), e & 127); }
        __syncthreads();
#pragma unroll
        for (int i = 0; i < 2; ++i) { const int e = tid + i * 512; As[(e & 15) * 68 + (e >> 4)] = av[i]; }
#pragma unroll
        for (int i = 0; i < 4; ++i) { const int e = tid + i * 512; Bs[(e >> 7) * 128 + (e & 127)] = bv[i]; }
        __syncthreads();
#pragma unroll
        for (int kk = 0; kk < 16; ++kk) {
            const f32x4 a = *(const LAS f32x4*)(As + kk * 68 + ty * 4);
            const f32x4 b = *(const LAS f32x4*)(Bs + kk * 128 + tx * 4);
#pragma unroll
            for (int i = 0; i < 4; ++i)
#pragma unroll
                for (int j = 0; j < 4; ++j) acc[i][j] += a[i] * b[j];
        }
    }
    __syncthreads();
}

__device__ __forceinline__ void ph_inproj_naive(Frame& F) {
    LAS float* sm = (LAS float*)F.lds;
    constexpr int NRT = (NROW + 63) / 64, NCT = INC / 128;
    bf16* Q = (bf16*)(F.ws + WS_Q); bf16* Kb = (bf16*)(F.ws + WS_K); bf16* Vb = (bf16*)(F.ws + WS_V); bf16* XR = (bf16*)(F.ws + WS_XR); bf16* GY = (bf16*)(F.ws + WS_GY);
    for (int t = F.bid; t < NRT * NCT; t += F.G) {
        const int rt = t / NCT, ct = t % NCT, r0 = rt * 64, c0 = ct * 128;
        const float* x = F.x; const float* meta = F.meta; const float* w = F.w_in;
        float acc[4][4];
        ngemm_tile(sm, DM,
            [&](int r, int k) -> float { const int row = r0 + r; if (row >= NROW) return 0.f; return row < NTOK ? x[(size_t)row * DM + k] : meta[(size_t)(row - NTOK) * DM + k]; },
            [&](int k, int c) -> float { return w[(size_t)k * INC + c0 + c]; }, acc, F.tid);
        const int ty = F.tid >> 5, tx = F.tid & 31;
#pragma unroll
        for (int i = 0; i < 4; ++i) {
            const int row = r0 + ty * 4 + i; if (row >= NROW) continue;
#pragma unroll
            for (int j = 0; j < 4; ++j) {
                const int c = c0 + tx * 4 + j; const float v = acc[i][j];
                if (c < 512) { if (row < NTOK) Q[(size_t)row * 512 + c] = (bf16)f2bf(v); }
                else if (c < 640) Kb[(size_t)row * 128 + (c - 512)] = (bf16)f2bf(v);
                else if (c < 768) Vb[(size_t)row * 128 + (c - 640)] = (bf16)f2bf(v);
                else if (c < 1280) XR[(size_t)row * 512 + (c - 768)] = (bf16)f2bf(v);
                else if (row < NTOK) GY[(size_t)row * 512 + (c - 1280)] = (bf16)f2bf(gelu_tanh(v));
            }
        }
    }
}

__device__ __forceinline__ void ph_attn_naive(Frame& F) {
    const bf16* Q = (const bf16*)(F.ws + WS_Q); const bf16* Kb = (const bf16*)(F.ws + WS_K); const bf16* Vb = (const bf16*)(F.ws + WS_V);
    float* ATT = (float*)(F.ws + WS_ATT);
    const int gw = F.bid * NWAVES + F.wave, NGW = F.G * NWAVES, lane = F.lane;
    for (int it = gw; it < NTOK * NQH; it += NGW) {
        const int row = it >> 3, hq = it & 7, kvh = hq >> 2, b = row >> 12, s = row & 4095;
        const float slope = exp2f(-(float)(hq + 1)), sink = F.sinks[hq];
        const bf16* q = Q + (size_t)row * 512 + hq * 64;
        float lg[2]; int krow[2];
#pragma unroll
        for (int h = 0; h < 2; ++h) {
            const int o = lane + 64 * h, tt = s + 16 - o;
            krow[h] = -1; lg[h] = -1e30f;
            if (tt >= 0) {
                krow[h] = tt >= 16 ? b * SEQ + (tt - 16) : NTOK + tt;
                const bf16* k = Kb + (size_t)krow[h] * 128 + kvh * 64;
                float d = 0.f;
                for (int c = 0; c < 64; ++c) d += bf2f(q[c]) * bf2f(k[c]);
                lg[h] = d * 0.125f - slope * (float)o;
            }
        }
        const float m = fmaxf(wave_max(fmaxf(lg[0], lg[1])), sink);
        float p0 = krow[0] >= 0 ? __expf(lg[0] - m) : 0.f, p1 = krow[1] >= 0 ? __expf(lg[1] - m) : 0.f;
        const float den = wave_sum(p0 + p1) + __expf(sink - m);
        float o_acc = 0.f;
        for (int o = 0; o < 128; ++o) {
            const float p = __shfl(o < 64 ? p0 : p1, o & 63);
            const int kr = __shfl(o < 64 ? krow[0] : krow[1], o & 63);
            if (kr >= 0) o_acc += p * bf2f(Vb[(size_t)kr * 128 + kvh * 64 + lane]);
        }
        ATT[(size_t)row * 512 + hq * 64 + lane] = o_acc / den;
    }
}

__device__ __forceinline__ float xr_at(const bf16* XR, int b, int tt, int ch) {
    if (tt < 0) return 0.f;
    const int row = tt >= 16 ? b * SEQ + (tt - 16) : NTOK + tt;
    return bf2f(XR[(size_t)row * 512 + ch]);
}
__device__ __forceinline__ void ph_gates_naive(Frame& F) {
    const bf16* XR = (const bf16*)(F.ws + WS_XR);
    float* A_ = (float*)(F.ws + WS_AU_A); float* U_ = (float*)(F.ws + WS_AU_U);
    const int gt = F.bid * NTHR + F.tid, NGT = F.G * NTHR;
    for (int it = gt; it < NROW * 512; it += NGT) {
        const int row = it >> 9, ch = it & 511, n = ch >> 6, d = ch & 63;
        int b, tt; if (row < NTOK) { b = row >> 12; tt = (row & 4095) + 16; } else { b = 0; tt = row - NTOK; }
        float rp = F.ba[ch], ip = F.bx[ch], xcd = 0.f;
        for (int c = 0; c < 64; ++c) {
            const int cc = n * 64 + c;
            float xc = F.conv_b[cc];
#pragma unroll
            for (int k = 0; k < 4; ++k) xc += F.conv_w[k * 512 + cc] * xr_at(XR, b, tt - 3 + k, cc);
            rp += xc * F.wa[(n * 64 + c) * 64 + d]; ip += xc * F.wx[(n * 64 + c) * 64 + d];
            if (c == d) xcd = xc;
        }
        const float r = sigmoidf_(rp), ig = sigmoidf_(ip);
        const float nl = -F.lam[ch], sp = fmaxf(nl, 0.f) + log1pf(__expf(-fabsf(nl)));
        const float log_a = -8.0f * r * sp, a = __expf(log_a);
        const float u = sqrtf(fmaxf(-expm1f(2.f * log_a), 0.f)) * (ig * xcd);
        A_[it] = a; U_[it] = u;
    }
}
__device__ __forceinline__ void ph_scan_naive(Frame& F) {
    const float* A_ = (const float*)(F.ws + WS_AU_A); const float* U_ = (const float*)(F.ws + WS_AU_U);
    float* HL = (float*)(F.ws + WS_HL);
    const int gt = F.bid * NTHR + F.tid;
    if (gt < NB * 512) {
        const int b = gt >> 9, ch = gt & 511; float h = 0.f;
        for (int m = 0; m < NMETA; ++m) { const size_t i = (size_t)(NTOK + m) * 512 + ch; h = A_[i] * h + U_[i]; }
        for (int s = 0; s < SEQ; ++s) { const size_t i = (size_t)(b * SEQ + s) * 512 + ch; h = A_[i] * h + U_[i]; HL[i] = h; }
    }
}
__device__ __forceinline__ void ph_merge_naive(Frame& F) {
    const float* ATT = (const float*)(F.ws + WS_ATT); const float* HL = (const float*)(F.ws + WS_HL); const bf16* GY = (const bf16*)(F.ws + WS_GY);
    bf16* MRG = (bf16*)(F.ws + WS_MRG);
    const int gw = F.bid * NWAVES + F.wave, NGW = F.G * NWAVES, lane = F.lane;
    for (int row = gw; row < NTOK; row += NGW) {
        float a[8], l[8], sa = 0.f, sl = 0.f;
#pragma unroll
        for (int j = 0; j < 8; ++j) { const int c = lane + 64 * j; a[j] = ATT[(size_t)row * 512 + c]; l[j] = HL[(size_t)row * 512 + c] * bf2f(GY[(size_t)row * 512 + c]); sa += a[j] * a[j]; sl += l[j] * l[j]; }
        const float ra = 1.f / sqrtf(wave_sum(sa) * (1.f / 512.f) + EPS), rl = 1.f / sqrtf(wave_sum(sl) * (1.f / 512.f) + EPS);
#pragma unroll
        for (int j = 0; j < 8; ++j) { const int c = lane + 64 * j;
            MRG[(size_t)row * 1024 + c] = (bf16)f2bf(a[j] * ra * F.g_attn[c]); MRG[(size_t)row * 1024 + 512 + c] = (bf16)f2bf(l[j] * rl * F.g_lru[c]); }
    }
}
__device__ __forceinline__ void ph_outproj_naive(Frame& F) {
    LAS float* sm = (LAS float*)F.lds;
    const bf16* MRG = (const bf16*)(F.ws + WS_MRG); float* Z = (float*)(F.ws + WS_Z);
    constexpr int NRT = NTOK / 64, NCT = DM / 128;
    for (int t = F.bid; t < NRT * NCT; t += F.G) {
        const int rt = t / NCT, ct = t % NCT, r0 = rt * 64, c0 = ct * 128; const float* w = F.w_out;
        float acc[4][4];
        ngemm_tile(sm, DM, [&](int r, int k) -> float { return bf2f(MRG[(size_t)(r0 + r) * 1024 + k]); },
                            [&](int k, int c) -> float { return w[(size_t)k * DM + c0 + c]; }, acc, F.tid);
        const int ty = F.tid >> 5, tx = F.tid & 31;
#pragma unroll
        for (int i = 0; i < 4; ++i) { const int row = r0 + ty * 4 + i;
#pragma unroll
            for (int j = 0; j < 4; ++j) { const int c = c0 + tx * 4 + j; Z[(size_t)row * DM + c] = ALPHA * F.x[(size_t)row * DM + c] + acc[i][j]; } }
    }
}
__device__ __forceinline__ void ph_router(Frame& F) {
    const float* Z = (const float*)(F.ws + WS_Z); bf16* H1B = (bf16*)(F.ws + WS_H1B);
    int* LIST = (int*)(F.ws + WS_LIST); float* GATE = (float*)(F.ws + WS_GATE); unsigned* cnt = F.ctl + CW_CNT;
    const int gw = F.bid * NWAVES + F.wave, NGW = F.G * NWAVES, lane = F.lane;
    for (int row = gw; row < NTOK; row += NGW) {
        float v[16]; float s = 0.f;
#pragma unroll
        for (int j = 0; j < 16; ++j) { v[j] = Z[(size_t)row * DM + lane + 64 * j]; s += v[j]; }
        const float mu = wave_sum(s) * (1.f / DM); float q = 0.f;
#pragma unroll
        for (int j = 0; j < 16; ++j) { v[j] -= mu; q += v[j] * v[j]; }
        const float rstd = 1.f / sqrtf(wave_sum(q) * (1.f / DM) + EPS);
#pragma unroll
        for (int j = 0; j < 16; ++j) { const int c = lane + 64 * j; v[j] = v[j] * rstd * F.ln1g[c] + F.ln1b[c]; H1B[(size_t)row * DM + c] = (bf16)f2bf(v[j]); }
        float gl[4];
#pragma unroll
        for (int g = 0; g < 4; ++g) { float p = 0.f;
#pragma unroll
            for (int j = 0; j < 16; ++j) p += v[j] * F.w_group[(size_t)(lane + 64 * j) * 4 + g];
            gl[g] = wave_sum(p) + F.b_group[g]; }
        int gi = 0; float gm = gl[0];
#pragma unroll
        for (int g = 1; g < 4; ++g) if (gl[g] > gm) { gm = gl[g]; gi = g; }
        float gs = 0.f;
#pragma unroll
        for (int g = 0; g < 4; ++g) gs += __expf(gl[g] - gm);
        const float gw_ = 1.f / gs;
        float el[8];
#pragma unroll
        for (int e = 0; e < 8; ++e) { float p = 0.f;
#pragma unroll
            for (int j = 0; j < 16; ++j) p += v[j] * F.w_router[((size_t)gi * DM + lane + 64 * j) * 8 + e];
            el[e] = wave_sum(p) + F.b_router[gi * 8 + e]; }
        int i1 = 0; float v1 = el[0];
#pragma unroll
        for (int e = 1; e < 8; ++e) if (el[e] > v1) { v1 = el[e]; i1 = e; }
        int i2 = -1; float v2 = -3.0e38f;
#pragma unroll
        for (int e = 0; e < 8; ++e) if (e != i1 && el[e] > v2) { v2 = el[e]; i2 = e; }
        const float e2 = __expf(v2 - v1), w1 = gw_ / (1.f + e2), w2 = gw_ * e2 / (1.f + e2);
        if (lane < 2) {
            const int e = gi * 8 + (lane == 0 ? i1 : i2); const int slot = row * 2 + lane;
            const unsigned pos = __hip_atomic_fetch_add(cnt + e, 1u, RLX_AGENT);
            LIST[(size_t)e * NTOK + pos] = slot; GATE[slot] = lane == 0 ? w1 : w2;
        }
    }
}
__device__ __forceinline__ void moe_find(const unsigned* cnt, int tile_rows, int t, int& e, int& rt, int& p256, int& n) {
    int acc = 0, pad = 0; e = -1; rt = 0; p256 = 0; n = 0;
    for (int i = 0; i < NEXP; ++i) { const int c = (int)cnt[i], nt = (c + tile_rows - 1) / tile_rows;
        if (e < 0 && t < acc + nt) { e = i; rt = t - acc; p256 = pad; n = c; }
        acc += nt; pad += (c + 255) / 256 * 256; }
}
__device__ __forceinline__ int moe_total(const unsigned* cnt, int tile_rows) { int acc = 0; for (int i = 0; i < NEXP; ++i) acc += ((int)cnt[i] + tile_rows - 1) / tile_rows; return acc; }

__device__ __forceinline__ void ph_moe1_naive(Frame& F) {
    LAS float* sm = (LAS float*)F.lds;
    const bf16* H1B = (const bf16*)(F.ws + WS_H1B); const int* LIST = (const int*)(F.ws + WS_LIST); bf16* HID = (bf16*)(F.ws + WS_HID);
    const unsigned* cnt = F.ctl + CW_CNT;
    const int ntile = moe_total(cnt, 64);
    for (int t = F.bid; t < ntile * 4; t += F.G) {
        const int ct = t & 3; int e, rt, p256, n; moe_find(cnt, 64, t >> 2, e, rt, p256, n);
        const int* lst = LIST + (size_t)e * NTOK + rt * 64; const int nrow = n - rt * 64;
        const float* wg = F.w_gate + (size_t)e * DM * DFF + ct * 128; const float* wu = F.w_up + (size_t)e * DM * DFF + ct * 128;
        float ag[4][4], au[4][4];
        auto af = [&](int r, int k) -> float { const int tok = (r < nrow ? lst[r] : lst[0]) >> 1; return bf2f(H1B[(size_t)tok * DM + k]); };
        ngemm_tile(sm, DM, af, [&](int k, int c) -> float { return wg[(size_t)k * DFF + c]; }, ag, F.tid);
        ngemm_tile(sm, DM, af, [&](int k, int c) -> float { return wu[(size_t)k * DFF + c]; }, au, F.tid);
        const int ty = F.tid >> 5, tx = F.tid & 31;
#pragma unroll
        for (int i = 0; i < 4; ++i) { const int r = ty * 4 + i; if (r >= nrow) continue;
#pragma unroll
            for (int j = 0; j < 4; ++j) { const float g = ag[i][j]; HID[(size_t)(p256 + rt * 64 + r) * DFF + ct * 128 + tx * 4 + j] = (bf16)f2bf(g * sigmoidf_(g) * au[i][j]); } }
    }
}
__device__ __forceinline__ void ph_moe2_naive(Frame& F) {
    LAS float* sm = (LAS float*)F.lds;
    const int* LIST = (const int*)(F.ws + WS_LIST); const float* GATE = (const float*)(F.ws + WS_GATE); const bf16* HID = (const bf16*)(F.ws + WS_HID); bf16* YB = (bf16*)(F.ws + WS_YB);
    const unsigned* cnt = F.ctl + CW_CNT;
    const int ntile = moe_total(cnt, 64);
    for (int t = F.bid; t < ntile * 8; t += F.G) {
        const int ct = t & 7; int e, rt, p256, n; moe_find(cnt, 64, t >> 3, e, rt, p256, n);
        const int* lst = LIST + (size_t)e * NTOK + rt * 64; const int nrow = n - rt * 64;
        const float* wd = F.w_down + (size_t)e * DFF * DM + ct * 128; const bf16* hid = HID + (size_t)(p256 + rt * 64) * DFF;
        float acc[4][4];
        ngemm_tile(sm, DFF, [&](int r, int k) -> float { return r < nrow ? bf2f(hid[(size_t)r * DFF + k]) : 0.f; },
                             [&](int k, int c) -> float { return wd[(size_t)k * DM + c]; }, acc, F.tid);
        const int ty = F.tid >> 5, tx = F.tid & 31;
#pragma unroll
        for (int i = 0; i < 4; ++i) { const int r = ty * 4 + i; if (r >= nrow) continue; const int slot = lst[r]; const float g = GATE[slot];
#pragma unroll
            for (int j = 0; j < 4; ++j) YB[(size_t)slot * DM + ct * 128 + tx * 4 + j] = (bf16)f2bf(g * acc[i][j]); }
    }
}
__device__ __forceinline__ void ph_ln2(Frame& F) {
    const bf16* H1B = (const bf16*)(F.ws + WS_H1B); const bf16* YB = (const bf16*)(F.ws + WS_YB);
    const int gw = F.bid * NWAVES + F.wave, NGW = F.G * NWAVES, lane = F.lane;
    for (int row = gw; row < NTOK; row += NGW) {
        float v[16]; float s = 0.f;
#pragma unroll
        for (int j = 0; j < 16; ++j) { const int c = lane + 64 * j;
            v[j] = ALPHA * bf2f(H1B[(size_t)row * DM + c]) + bf2f(YB[(size_t)(2 * row) * DM + c]) + bf2f(YB[(size_t)(2 * row + 1) * DM + c]); s += v[j]; }
        const float mu = wave_sum(s) * (1.f / DM); float q = 0.f;
#pragma unroll
        for (int j = 0; j < 16; ++j) { v[j] -= mu; q += v[j] * v[j]; }
        const float rstd = 1.f / sqrtf(wave_sum(q) * (1.f / DM) + EPS);
#pragma unroll
        for (int j = 0; j < 16; ++j) { const int c = lane + 64 * j; F.out[(size_t)row * DM + c] = v[j] * rstd * F.ln2g[c] + F.ln2b[c]; }
    }
}

constexpr int N_PHASES = 12;
__global__ void __launch_bounds__(NTHR, 2) hymba_fwd(Args args) {
    extern __shared__ __attribute__((aligned(16))) unsigned char lds[];
    Frame F;
    F.lds = (LAS unsigned char*)lds;
    F.tid = threadIdx.x; F.lane = F.tid & 63; F.wave = __builtin_amdgcn_readfirstlane(F.tid >> 6); F.G = gridDim.x; F.bid = blockIdx.x;
    F.x = args.in[0]; F.meta = args.in[1]; F.w_in = args.in[2]; F.conv_w = args.in[3]; F.conv_b = args.in[4]; F.wa = args.in[5]; F.ba = args.in[6]; F.wx = args.in[7]; F.bx = args.in[8];
    F.lam = args.in[9]; F.sinks = args.in[10]; F.g_attn = args.in[11]; F.g_lru = args.in[12]; F.w_out = args.in[13]; F.ln1g = args.in[14]; F.ln1b = args.in[15];
    F.w_group = args.in[16]; F.b_group = args.in[17]; F.w_router = args.in[18]; F.b_router = args.in[19]; F.w_gate = args.in[20]; F.w_up = args.in[21]; F.w_down = args.in[22];
    F.ln2g = args.in[23]; F.ln2b = args.in[24]; F.out = args.out; F.ws = args.ws; F.ctl = (unsigned*)(args.ws + WS_CTL);
    volatile LAS unsigned* MISC = (volatile LAS unsigned*)(F.lds + MISC_OFF);
    if (F.tid < 32) MISC[F.tid] = 0u;
    __syncthreads();
    XcdBarrier bar; bar.bar = F.ctl + CW_BAR; bar.x = 0; bar.st = nullptr;
    const int lo = args.ph_lo, hi = args.ph_hi;
    if (hi - lo > 1) bar = xcd_barrier_post(F.ctl + CW_BAR, MISC + 8);
#define IN(k) (lo <= (k) && (k) < hi)
#define SEAM(k) do { if (IN(k) && IN((k) + 1)) xcd_barrier(bar); } while (0)
    if (IN(0)) ph_convert(F);       SEAM(0);
    if (IN(1)) {
        pg8::Gemm g{(const pg8::bf16_t*)(F.ws + WS_XB), (const pg8::bf16_t*)(F.ws + WS_WINT), 16640, INC, DM}; pg8::InProjOrder S; S.init(F.G, F.bid);
        pg8::EpiInProj E{(bf16*)(F.ws + WS_Q), (bf16*)(F.ws + WS_K), (bf16*)(F.ws + WS_V), (bf16*)(F.ws + WS_XR), (bf16*)(F.ws + WS_GY)};
        pg8::gemm_phase<pg8::EpiInProj, pg8::InProjOrder, true, true>(F.lds, g, S, E);
    }
    SEAM(1);
    if (IN(2)) ph_attn(F);          SEAM(2);
    if (IN(3)) ph_lru_local(F);     SEAM(3);
    if (IN(4)) { }                  SEAM(4);
    if (IN(5)) ph_merge(F);         SEAM(5);
    if (IN(6)) {
        pg8::Gemm g{(const pg8::bf16_t*)(F.ws + WS_MRG), (const pg8::bf16_t*)(F.ws + WS_WOUTT), NTOK, DM, DM}; pg8::StaticOrder S; S.init(NTOK, DM, F.G, F.bid);
        pg8::EpiZ E{F.x, (float*)(F.ws + WS_Z), ALPHA};
        pg8::gemm_phase<pg8::EpiZ, pg8::StaticOrder, true, true>(F.lds, g, S, E);
    }
    SEAM(6);
    if (IN(7)) ph_router(F);        SEAM(7);
    if (IN(8)) ph_convert_moe(F);   SEAM(8);
    if (IN(9)) {
        pg8::Gemm g{(const pg8::bf16_t*)(F.ws + WS_H1B), (const pg8::bf16_t*)(F.ws + WS_WGUT), 0, 1024, DM};
        pg8::MoeOrder S{F.ctl + CW_CNT, (const int*)(F.ws + WS_LIST), F.G, F.bid, 4, (size_t)1024 * DM * 2, true};
        pg8::EpiHid E{(bf16*)(F.ws + WS_HID)};
        pg8::gemm_phase<pg8::EpiHid, pg8::MoeOrder, true, true, true>(F.lds, g, S, E);
    }
    SEAM(9);
    if (IN(10)) {
        pg8::Gemm g{(const pg8::bf16_t*)(F.ws + WS_HID), (const pg8::bf16_t*)(F.ws + WS_WDT), 0, 1024, DFF};
        pg8::MoeOrder S{F.ctl + CW_CNT, (const int*)(F.ws + WS_LIST), F.G, F.bid, 4, (size_t)DM * DFF * 2, false};
        pg8::EpiYB E{(bf16*)(F.ws + WS_YB), (const int*)(F.ws + WS_LIST), (const float*)(F.ws + WS_GATE), F.ctl + CW_CNT};
        pg8::gemm_phase<pg8::EpiYB, pg8::MoeOrder, true, true, false>(F.lds, g, S, E);
    }
    SEAM(10);
    if (IN(11)) ph_ln2(F);
#undef IN
#undef SEAM
}

extern "C" void kernel_launch(void* const* d_in, const int* in_sizes, int n_in, void* d_out, int out_size, void* d_ws, size_t ws_size, hipStream_t stream) {
    static int grid = 0;
    if (grid == 0) {
        if (n_in != 25 || in_sizes[0] != NTOK * DM || out_size != NTOK * DM || ws_size < WS_END) {
            fprintf(stderr, "kernel_launch: unexpected shapes: n_in %d in0 %d out %d ws %zu (need %zu)\n", n_in, n_in > 0 ? in_sizes[0] : -1, out_size, ws_size, (size_t)WS_END); grid = -1; return; }
        int dev = 0, cus = 0, per_cu = 0;
        if (hipGetDevice(&dev) != hipSuccess || hipDeviceGetAttribute(&cus, hipDeviceAttributeMultiprocessorCount, dev) != hipSuccess) { grid = -1; return; }
        if (hipFuncSetAttribute((const void*)hymba_fwd, hipFuncAttributeMaxDynamicSharedMemorySize, LDS_BYTES) != hipSuccess) { fprintf(stderr, "kernel_launch: hipFuncSetAttribute failed\n"); grid = -1; return; }
        if (hipOccupancyMaxActiveBlocksPerMultiprocessor(&per_cu, (const void*)hymba_fwd, NTHR, LDS_BYTES) != hipSuccess || per_cu < 1) { fprintf(stderr, "kernel_launch: occupancy query says %d\n", per_cu); per_cu = 1; }
        (void)hipGetLastError();
        grid = cus;
    }
    if (grid < 0) return;
    (void)hipMemsetAsync((char*)d_ws + WS_CTL, 0, CTL_ZERO_BYTES, stream);
    Args a{};
    for (int i = 0; i < 25; ++i) a.in[i] = (const float*)d_in[i];
    a.out = (float*)d_out; a.ws = (unsigned char*)d_ws;
#if ONE_LAUNCH
    a.ph_lo = 0; a.ph_hi = N_PHASES;
    hipLaunchKernelGGL(hymba_fwd, dim3(grid), dim3(NTHR), LDS_BYTES, stream, a);
#else
    for (int p = 0; p < N_PHASES; ++p) { a.ph_lo = p; a.ph_hi = p + 1; hipLaunchKernelGGL(hymba_fwd, dim3(grid), dim3(NTHR), LDS_BYTES, stream, a); }
#endif
}
```
